# Optimizing an MI355X kernel written in HIP

```python
import jax, jax.numpy as jnp
from jax import lax
import numpy as np

D_MODEL = 1024
BATCH = 8
SEQ = 4096
DEPTH = 4

CONV_WIDTH_A = 512
CONV_K = 3
MLA_HEADS = 8
MLA_NOPE = 64
MLA_ROPE = 32
MLA_V = 64
MLA_Q_RANK = 384
MLA_KV_RANK = 256
ROPE_THETA = 10000.0
ATTN_BLOCK = 128
GLA_HEADS = 4
GLA_DK = 128
GLA_DV = 256
GLA_GATE_RANK = 16
GLA_GATE_TAU = 16.0
GLA_CHUNK = 64
D_FF = 4 * D_MODEL
EPS = 1e-6

N_EVEN = (DEPTH + 1) // 2
N_ODD = DEPTH // 2
EVEN_SPLITS = (CONV_WIDTH_A, CONV_WIDTH_A, CONV_WIDTH_A, MLA_Q_RANK, MLA_KV_RANK, MLA_ROPE)
ODD_SPLITS = (GLA_HEADS * GLA_DK, GLA_HEADS * GLA_DK, GLA_HEADS * GLA_DV, GLA_HEADS * GLA_DV, GLA_GATE_RANK)
EVEN_IN = sum(EVEN_SPLITS)
ODD_IN = sum(ODD_SPLITS)
EVEN_MIX = CONV_WIDTH_A + MLA_HEADS * MLA_V

kernel_name = "hybrid_shortconv_mla_gla_sqrelu"


def rms_norm(x, g):
    xf = x.astype(jnp.float32)
    y = xf * lax.rsqrt(jnp.mean(xf * xf, axis=-1, keepdims=True) + EPS)
    return (y * g.astype(jnp.float32)).astype(x.dtype)


def split_cols(z, sizes):
    idx = [int(i) for i in np.cumsum(sizes)[:-1]]
    return jnp.split(z, idx, axis=-1)


def apply_rope(t, cos, sin):
    half = t.shape[-1] // 2
    t1, t2 = t[..., :half], t[..., half:]
    return jnp.concatenate([t1 * cos - t2 * sin, t2 * cos + t1 * sin], axis=-1)


def causal_short_conv(u, w):
    c = u.shape[-1]
    return lax.conv_general_dilated(
        u, w[:, None, :].astype(u.dtype), window_strides=(1,),
        padding=[(CONV_K - 1, 0)], dimension_numbers=("NWC", "WIO", "NWC"),
        feature_group_count=c)


def causal_attention_blocks(q, k, v):
    b, s, h, dq = q.shape
    dv = v.shape[-1]
    nb = s // ATTN_BLOCK
    scale = dq ** -0.5
    kt = k.transpose(0, 2, 1, 3)
    vt = v.transpose(0, 2, 1, 3)
    qb = q.reshape(b, nb, ATTN_BLOCK, h, dq).transpose(1, 0, 3, 2, 4)
    kpos = jnp.arange(s)

    def one_block(args):
        qi, i = args
        sc = jnp.einsum("bhqd,bhkd->bhqk", qi, kt, preferred_element_type=jnp.float32) * scale
        qpos = i * ATTN_BLOCK + jnp.arange(ATTN_BLOCK)
        sc = jnp.where(kpos[None, :] <= qpos[:, None], sc, -jnp.inf)
        p = jax.nn.softmax(sc, axis=-1).astype(vt.dtype)
        return jnp.einsum("bhqk,bhkd->bhqd", p, vt)

    o = lax.map(one_block, (qb, jnp.arange(nb)))
    return o.transpose(1, 0, 3, 2, 4).reshape(b, s, h * dv)


def gla_chunked(q, k, v, log_a):
    b, s, h, dk = q.shape
    dv = v.shape[-1]
    c = GLA_CHUNK
    n = s // c

    def chunks(t):
        return t.reshape(b, n, c, h, t.shape[-1]).transpose(1, 0, 3, 2, 4).astype(jnp.float32)

    qc = chunks(q) * (dk ** -0.5)
    kc = chunks(k)
    vc = chunks(v)
    bc = jnp.cumsum(chunks(log_a), axis=3)
    b_last = bc[:, :, :, -1:, :]
    q_e = qc * jnp.exp(bc)
    k_e = kc * jnp.exp(-bc)
    k_l = kc * jnp.exp(b_last - bc)
    dec = jnp.exp(b_last[:, :, :, 0, :])
    causal = jnp.tril(jnp.ones((c, c), dtype=bool))
    attn = jnp.where(causal, jnp.einsum("nbhid,nbhjd->nbhij", q_e, k_e), 0.0)
    o_intra = jnp.einsum("nbhij,nbhjv->nbhiv", attn, vc)

    def step(state, inp):
        q_n, k_n, v_n, dec_n = inp
        o_n = jnp.einsum("bhid,bhdv->bhiv", q_n, state)
        state = dec_n[..., None] * state + jnp.einsum("bhjd,bhjv->bhdv", k_n, v_n)
        return state, o_n

    state0 = jnp.zeros((b, h, dk, dv), jnp.float32)
    _, o_inter = lax.scan(step, state0, (q_e, k_l, vc, dec))
    o = (o_intra + o_inter).transpose(1, 0, 3, 2, 4).reshape(b, s, h, dv)
    return o.astype(v.dtype)


def even_mixer(h, cos, sin, w_in, conv_w, q_norm_g, w_qb, kv_norm_g, w_kvb, w_out):
    b, s, _ = h.shape
    z = h @ w_in
    a_b, a_c, a_v, z_q, z_kv, z_pe = split_cols(z, EVEN_SPLITS)
    y_a = a_b * causal_short_conv(a_c * a_v, conv_w)
    q = (rms_norm(z_q, q_norm_g) @ w_qb).reshape(b, s, MLA_HEADS, MLA_NOPE + MLA_ROPE)
    q = jnp.concatenate([q[..., :MLA_NOPE],
                         apply_rope(q[..., MLA_NOPE:], cos[:, :, None, :], sin[:, :, None, :])], axis=-1)
    kv = (rms_norm(z_kv, kv_norm_g) @ w_kvb).reshape(b, s, MLA_HEADS, MLA_NOPE + MLA_V)
    k_pe = apply_rope(z_pe, cos, sin)
    k = jnp.concatenate([kv[..., :MLA_NOPE],
                         jnp.broadcast_to(k_pe[:, :, None, :], (b, s, MLA_HEADS, MLA_ROPE))], axis=-1)
    y_b = causal_attention_blocks(q, k, kv[..., MLA_NOPE:])
    return jnp.concatenate([y_a, y_b], axis=-1) @ w_out


def odd_mixer(h, w_in, w_gate2, b_gate2, o_norm_g, w_out):
    b, s, _ = h.shape
    z = h @ w_in
    q, k, v, g, g_low = split_cols(z, ODD_SPLITS)
    log_a = jax.nn.log_sigmoid((g_low @ w_gate2 + b_gate2).astype(jnp.float32)) / GLA_GATE_TAU
    o = gla_chunked(q.reshape(b, s, GLA_HEADS, GLA_DK), k.reshape(b, s, GLA_HEADS, GLA_DK),
                    v.reshape(b, s, GLA_HEADS, GLA_DV), log_a.reshape(b, s, GLA_HEADS, GLA_DK))
    o = rms_norm(o, o_norm_g).reshape(b, s, GLA_HEADS * GLA_DV)
    return (o * jax.nn.silu(g)) @ w_out


def setup_inputs(seed: int = 0) -> dict:
    key = jax.random.key(seed)
    ks = jax.random.split(key, 20)
    resid = (2.0 * DEPTH) ** -0.5

    def nrm(k, shape, fan_in, scale=1.0):
        return jax.random.normal(k, shape, jnp.float32) * (scale * fan_in ** -0.5)

    def gain(k, shape):
        return 1.0 + 0.02 * jax.random.normal(k, shape, jnp.float32)

    x = jax.random.normal(ks[0], (BATCH, SEQ, D_MODEL), jnp.float32)
    offsets = jax.random.randint(ks[1], (BATCH, 1), 0, 4096, dtype=jnp.int32)
    positions = (offsets + jnp.arange(SEQ, dtype=jnp.int32)[None, :]).astype(jnp.int32)
    return {
        "x": x,
        "positions": positions,
        "mix_norm_g": gain(ks[2], (DEPTH, D_MODEL)),
        "mlp_norm_g": gain(ks[3], (DEPTH, D_MODEL)),
        "final_norm_g": gain(ks[4], (D_MODEL,)),
        "ev_w_in": nrm(ks[5], (N_EVEN, D_MODEL, EVEN_IN), D_MODEL),
        "ev_conv_w": nrm(ks[6], (N_EVEN, CONV_K, CONV_WIDTH_A), CONV_K),
        "ev_q_norm_g": gain(ks[7], (N_EVEN, MLA_Q_RANK)),
        "ev_w_qb": nrm(ks[8], (N_EVEN, MLA_Q_RANK, MLA_HEADS * (MLA_NOPE + MLA_ROPE)), MLA_Q_RANK),
        "ev_kv_norm_g": gain(ks[9], (N_EVEN, MLA_KV_RANK)),
        "ev_w_kvb": nrm(ks[10], (N_EVEN, MLA_KV_RANK, MLA_HEADS * (MLA_NOPE + MLA_V)), MLA_KV_RANK),
        "ev_w_out": nrm(ks[11], (N_EVEN, EVEN_MIX, D_MODEL), EVEN_MIX, resid),
        "od_w_in": nrm(ks[12], (N_ODD, D_MODEL, ODD_IN), D_MODEL),
        "od_w_gate2": nrm(ks[13], (N_ODD, GLA_GATE_RANK, GLA_HEADS * GLA_DK), GLA_GATE_RANK),
        "od_b_gate2": 0.1 * jax.random.normal(ks[14], (N_ODD, GLA_HEADS * GLA_DK), jnp.float32),
        "od_o_norm_g": gain(ks[15], (N_ODD, GLA_DV)),
        "od_w_out": nrm(ks[16], (N_ODD, GLA_HEADS * GLA_DV, D_MODEL), GLA_HEADS * GLA_DV, resid),
        "mlp_w1": nrm(ks[17], (DEPTH, D_MODEL, D_FF), D_MODEL),
        "mlp_w2": nrm(ks[18], (DEPTH, D_FF, D_MODEL), D_FF, resid),
    }


def reference(x, positions, mix_norm_g, mlp_norm_g, final_norm_g, ev_w_in, ev_conv_w,
              ev_q_norm_g, ev_w_qb, ev_kv_norm_g, ev_w_kvb, ev_w_out, od_w_in, od_w_gate2,
              od_b_gate2, od_o_norm_g, od_w_out, mlp_w1, mlp_w2):
    inv_freq = 1.0 / (ROPE_THETA ** (jnp.arange(0, MLA_ROPE, 2, dtype=jnp.float32) / MLA_ROPE))
    ang = positions.astype(jnp.float32)[..., None] * inv_freq
    cos = jnp.cos(ang).astype(x.dtype)
    sin = jnp.sin(ang).astype(x.dtype)
    for layer in range(DEPTH):
        j = layer // 2
        h = rms_norm(x, mix_norm_g[layer])
        if layer % 2 == 0:
            x = x + even_mixer(h, cos, sin, ev_w_in[j], ev_conv_w[j], ev_q_norm_g[j], ev_w_qb[j],
                               ev_kv_norm_g[j], ev_w_kvb[j], ev_w_out[j])
        else:
            x = x + odd_mixer(h, od_w_in[j], od_w_gate2[j], od_b_gate2[j], od_o_norm_g[j], od_w_out[j])
        h = rms_norm(x, mlp_norm_g[layer])
        x = x + jnp.square(jax.nn.relu(h @ mlp_w1[layer])) @ mlp_w2[layer]
    return rms_norm(x, final_norm_g)
```

```cpp
#include <hip/hip_runtime.h>
#include <hip/hip_cooperative_groups.h>
#include <hip/amd_detail/amd_hip_unsafe_atomics.h>
#include <cstdio>
#include <cstdint>
namespace cg = cooperative_groups;

#ifndef EN
#define EN 0xffff
#endif
#ifndef REP
#define REP 0
#endif
#ifndef EN2
#define EN2 7
#define XCOPY 0
#endif
#ifndef MULTI_LAUNCH
#define MULTI_LAUNCH 0
#endif

typedef unsigned short bf16_t;
typedef short bf16x8 __attribute__((ext_vector_type(8)));
typedef short s16x4 __attribute__((ext_vector_type(4)));
typedef float f32x4 __attribute__((ext_vector_type(4)));
typedef float f32x16 __attribute__((ext_vector_type(16)));
typedef unsigned u32x4 __attribute__((ext_vector_type(4)));
typedef unsigned u32x2 __attribute__((ext_vector_type(2)));
#define DI __device__ __forceinline__

constexpr int R = 32768;
constexpr int SEQ = 4096;
constexpr int DM = 1024;
constexpr int DFF = 4096;
constexpr int EV_IN = 2208, EV_IN_PAD = 2304, EV_ZLD = 2176;
constexpr int OD_IN = 3088, OD_IN_PAD = 3328, OD_ZLD = 3072;
constexpr float EPS = 1e-6f;
constexpr float QSCALE = 0.10206207261596575f * 1.4426950408889634f;
constexpr float GLA_QSCALE = 0.08838834764831845f;
constexpr int NTHREADS = 512;
constexpr int LDS_BYTES = 131072 + 64;

constexpr size_t WT_EVIN = 0;
constexpr size_t WT_EVQ = WT_EVIN + (size_t)2 * EV_IN_PAD * 1024 * 2;
constexpr size_t WT_EVKV = WT_EVQ + (size_t)2 * 768 * 384 * 2;
constexpr size_t WT_EVOUT = WT_EVKV + (size_t)2 * 1024 * 256 * 2;
constexpr size_t WT_ODIN = WT_EVOUT + (size_t)2 * 1024 * 1024 * 2;
constexpr size_t WT_ODOUT = WT_ODIN + (size_t)2 * OD_IN_PAD * 1024 * 2;
constexpr size_t WT_W1 = WT_ODOUT + (size_t)2 * 1024 * 1024 * 2;
constexpr size_t WT_W2 = WT_W1 + (size_t)4 * 4096 * 1024 * 2;
constexpr size_t OFF_XB = WT_W2 + (size_t)4 * 4096 * 1024 * 2;
constexpr size_t OFF_SQ = OFF_XB + (size_t)R * 1024 * 2;
constexpr size_t SQ_FLOATS = (size_t)21 * R;
constexpr size_t OFF_COS = OFF_SQ + SQ_FLOATS * 8;
constexpr size_t OFF_SIN = OFF_COS + (size_t)R * 16 * 4;
constexpr size_t OFF_GLOW = OFF_SIN + (size_t)R * 16 * 4;
constexpr size_t OFF_BAR = OFF_GLOW + (size_t)R * 16 * 4;
constexpr size_t OFF_U = OFF_BAR + 16384;
constexpr size_t U_HID = OFF_U;
constexpr size_t U_Z = OFF_U;
constexpr size_t U_EV_MIX = OFF_U + (size_t)R * EV_ZLD * 2;
constexpr size_t U_EV_Q = U_EV_MIX + (size_t)R * 1024 * 2;
constexpr size_t U_EV_K = U_EV_Q + (size_t)64 * 4096 * 96 * 2;
constexpr size_t U_EV_VT = U_EV_K + (size_t)64 * 4096 * 96 * 2;
constexpr size_t U_EV_END = U_EV_VT + (size_t)64 * 64 * 4096 * 2;
constexpr size_t U_OD_MIX = OFF_U + (size_t)R * OD_ZLD * 2;
constexpr size_t U_OD_KLT = U_OD_MIX + (size_t)R * 1024 * 2;
constexpr size_t U_OD_AT = U_OD_KLT + (size_t)2048 * 128 * 64 * 2;
constexpr size_t U_OD_DEC = U_OD_AT + (size_t)2048 * 64 * 64 * 2;
constexpr size_t U_OD_END = U_OD_DEC + (size_t)2048 * 128 * 4;
constexpr size_t U_HID_END = U_HID + (size_t)R * 4096 * 2;
constexpr size_t WS_NEED = (U_EV_END > U_OD_END ? (U_EV_END > U_HID_END ? U_EV_END : U_HID_END) : (U_OD_END > U_HID_END ? U_OD_END : U_HID_END));

struct Params {
    const float* x; const int* pos; const float* mix_g; const float* mlp_g; const float* fin_g;
    const float* ev_w_in; const float* ev_conv; const float* ev_qg; const float* ev_wqb; const float* ev_kvg; const float* ev_wkvb; const float* ev_wout;
    const float* od_w_in; const float* od_wg2; const float* od_bg2; const float* od_og; const float* od_wout;
    const float* w1; const float* w2;
    float* out; unsigned char* ws; int lo, hi;
};

DI unsigned pk2(float a, float b) {
    typedef __bf16 bf2 __attribute__((ext_vector_type(2)));
    bf2 v; v.x = (__bf16)a; v.y = (__bf16)b; return __builtin_bit_cast(unsigned, v);
}
DI bf16_t f2bf(float a) { __bf16 v = (__bf16)a; return __builtin_bit_cast(bf16_t, v); }
DI float bf2f(bf16_t u) { return __uint_as_float(((unsigned)u) << 16); }
DI float bflo(unsigned u) { return __uint_as_float(u << 16); }
DI float bfhi(unsigned u) { return __uint_as_float(u & 0xffff0000u); }
DI void st_bf4(bf16_t* p, f32x4 v) { u32x2 w; w.x = pk2(v[0], v[1]); w.y = pk2(v[2], v[3]); *(u32x2*)p = w; }
DI int TID(int wv) { int lane; asm volatile("v_mbcnt_lo_u32_b32 %0, -1, 0\n\tv_mbcnt_hi_u32_b32 %0, -1, %0" : "=v"(lane)); asm volatile("" : "+s"(wv)); return wv * 64 + lane; }
DI int BID() { int b = blockIdx.x; asm volatile("" : "+s"(b)); return b; }
DI int GDIM() { int g = gridDim.x; asm volatile("" : "+s"(g)); return g; }
DI void st_bf8_sw(bf16_t* p32, f32x4 v0, f32x4 v1, int fq) {
    const unsigned a0 = pk2(v0[0], v0[1]), a1 = pk2(v0[2], v0[3]), b0 = pk2(v1[0], v1[1]), b1 = pk2(v1[2], v1[3]);
    const auto r0 = __builtin_amdgcn_permlane16_swap(a0, b0, false, false);
    const auto r1 = __builtin_amdgcn_permlane16_swap(a1, b1, false, false);
    u32x4 w; w.x = r0[0]; w.y = r1[0]; w.z = r0[1]; w.w = r1[1];
    *(u32x4*)(p32 + 8 * (fq >> 1) + 16 * (fq & 1)) = w;
}
DI void st_bf8_sw32(bf16_t* p16, f32x4 ga, f32x4 gb, int h) {
    const unsigned a0 = pk2(ga[0], ga[1]), a1 = pk2(ga[2], ga[3]), b0 = pk2(gb[0], gb[1]), b1 = pk2(gb[2], gb[3]);
    const auto r0 = __builtin_amdgcn_permlane32_swap(a0, b0, false, false);
    const auto r1 = __builtin_amdgcn_permlane32_swap(a1, b1, false, false);
    u32x4 w; w.x = r0[0]; w.y = r1[0]; w.z = r0[1]; w.w = r1[1];
    *(u32x4*)(p16 + 8 * h) = w;
}
DI int crow(int reg, int h) { return (reg & 3) + 8 * (reg >> 2) + 4 * h; }
#define MFMA32(a, b, c) __builtin_amdgcn_mfma_f32_32x32x16_bf16((a), (b), (c), 0, 0, 0)
#define MFMA16(a, b, c) __builtin_amdgcn_mfma_f32_16x16x32_bf16((a), (b), (c), 0, 0, 0)
DI bf16x8 pack8(const f32x16& x, int s) {
    u32x4 p; p.x = pk2(x[8 * s], x[8 * s + 1]); p.y = pk2(x[8 * s + 2], x[8 * s + 3]); p.z = pk2(x[8 * s + 4], x[8 * s + 5]); p.w = pk2(x[8 * s + 6], x[8 * s + 7]);
    return __builtin_bit_cast(bf16x8, p);
}

constexpr int BM = 256, BK = 64, HALF = 128, NXCD = 8, WGM = 8, HT = HALF * BK;
DI int lds_byte(int r, int c) { int st = (r >> 4) * 2 + (c >> 5), rr = r & 15, cc = c & 31, ob = rr * 64 + cc * 2; return st * 1024 + (ob ^ (((ob >> 9) & 1) << 5)); }
DI void stage_rc(int b, int& Rr, int& Cc) { int st = b / 1024, sb = b % 1024, swz = sb ^ (((sb >> 9) & 1) << 5); Rr = (st >> 1) * 16 + swz / 64; Cc = (st & 1) * 32 + (swz % 64) / 2; }

#define LAS __attribute__((address_space(3)))
template <class Epi>
DI void gemm_phase(int wv, unsigned char* smem, const bf16_t* __restrict__ A, int lda, const bf16_t* __restrict__ Bt  , int rev  , int K, int nM, int nN, const Epi& epi) {
    LAS unsigned char* lds = (LAS unsigned char*)smem;
    const int tid = TID(wv); const int bid = BID(), gdim = GDIM();
    const int wid = __builtin_amdgcn_readfirstlane(tid >> 6), lane = tid & 63, wr = wid >> 2, wc = wid & 3, fr = lane & 15, fq = lane >> 4;
    const int nwg = nM * nN, nt = K / BK, ldb = nN * BM;
    unsigned voffA[2], voffB[2];
#pragma unroll
    for (int i = 0; i < 2; ++i) { int r_, c_; stage_rc(tid * 16 + i * 8192, r_, c_); voffA[i] = (unsigned)(r_ * lda + c_) * 2u;
        const unsigned b_ = (unsigned)(tid * 16 + i * 8192), krow = b_ >> 8, chp = (b_ >> 4) & 15u, ch = chp ^ (((krow & 3u) << 2) | ((krow >> 2) & 3u));
        voffB[i] = (krow * (unsigned)ldb + ch * 8u) * 2u; }
    const size_t kstep = (size_t)(BK * 2), kstepB = (size_t)BK * ldb * 2;
    const size_t hstepA = (size_t)HALF * lda * 2, hstepB = (size_t)HALF * 2;
    const unsigned ldsw = (unsigned)wid * 1024u;
    const int aoff = lds_byte(wr * 64 + fr, fq * 8);
    unsigned trb[2][2];
    { const unsigned gq = (unsigned)fq, q = (unsigned)(fr >> 2), p = (unsigned)(fr & 3);
#pragma unroll
      for (int n = 0; n < 2; ++n)
#pragma unroll
          for (int t = 0; t < 2; ++t)
              trb[n][t] = (unsigned)(size_t)lds + 256u * (8u * gq + 4u * t + q) + 16u * (4u * ((unsigned)wc ^ q) + 2u * ((unsigned)n ^ (gq & 1u)) + ((p >> 1) ^ (unsigned)t)) + 8u * (p & 1u); }
    constexpr int HTB = HALF * BK * 2;
#define G_SA(b, h) ((4 + (b) * 2 + (h)) * HTB)
#define G_SB(b, h) (((b) * 2 + (h)) * HTB)
#define G_STAGE(bufoff, gbase, voff) do { const char* _ub = (gbase); asm volatile("" : "+s"(_ub)); _Pragma("unroll") for (int _i = 0; _i < 2; ++_i) \
        __builtin_amdgcn_global_load_lds((const unsigned*)(_ub + (voff)[_i]), (LAS unsigned*)(lds + (bufoff) + ldsw + _i * 8192), 16, 0, 0); } while (0)
#define G_LDA(dst, b, h) do { _Pragma("unroll") for (int m = 0; m < 4; ++m) _Pragma("unroll") for (int k = 0; k < 2; ++k) dst[m][k] = *(const LAS bf16x8*)(lds + G_SA(b, h) + aoff + m * 2048 + k * 1024); } while (0)
#define G_TR(dst_, addr_, imm_) asm volatile("ds_read_b64_tr_b16 %0, %1 offset:%2" : "=v"(dst_) : "v"(addr_), "n"(imm_) : "memory")
#define G_LDB(dst, b, h) do { _Pragma("unroll") for (int n = 0; n < 2; ++n) _Pragma("unroll") for (int k = 0; k < 2; ++k) _Pragma("unroll") for (int t = 0; t < 2; ++t) { \
        if (k == 0) G_TR(dst[n][k][t], trb[n][t], G_SB(b, h)); else G_TR(dst[n][k][t], trb[n][t], G_SB(b, h) + 8192); } } while (0)
#define G_FRAG(x) __builtin_bit_cast(bf16x8, __builtin_shufflevector((x)[0], (x)[1], 0, 1, 2, 3))
#define G_MMA(ai, bj, At_, Bt_) do { __builtin_amdgcn_s_setprio(1); _Pragma("unroll") for (int m = 0; m < 4; ++m) _Pragma("unroll") for (int n = 0; n < 2; ++n) _Pragma("unroll") for (int k = 0; k < 2; ++k) \
        acc[ai][bj][m][n] = MFMA16(G_FRAG(Bt_[n][k]), At_[m][k], acc[ai][bj][m][n]); __builtin_amdgcn_s_setprio(0); } while (0)
#define G_WAIT_V(n) asm volatile("s_waitcnt vmcnt(" #n ")" ::: "memory")
#define G_WAIT_L(n) asm volatile("s_waitcnt lgkmcnt(" #n ")" ::: "memory")
#define G_WAIT_LB() asm volatile("s_waitcnt lgkmcnt(0)" : "+v"(B0[0][0][0]), "+v"(B0[0][0][1]), "+v"(B0[0][1][0]), "+v"(B0[0][1][1]), "+v"(B0[1][0][0]), "+v"(B0[1][0][1]), "+v"(B0[1][1][0]), "+v"(B0[1][1][1]), \
        "+v"(B1[0][0][0]), "+v"(B1[0][0][1]), "+v"(B1[0][1][0]), "+v"(B1[0][1][1]), "+v"(B1[1][0][0]), "+v"(B1[1][0][1]), "+v"(B1[1][1][0]), "+v"(B1[1][1][1]) :: "memory")
#define G_BAR __builtin_amdgcn_s_barrier()
#define G_SCHED __builtin_amdgcn_sched_barrier(0)
#define TILE_RC(T_, BR_, BC_) do { int wgid = (T_); \
        { int q = nwg / NXCD, r = nwg % NXCD, xcd = wgid % NXCD, off = wgid / NXCD; if (rev && r == 0) off = q - 1 - off; wgid = (xcd < r ? xcd * (q + 1) : r * (q + 1) + (xcd - r) * q) + off; } \
        const int nig = WGM * nN, gid = wgid / nig, fm = gid * WGM, gsz = min(nM - fm, WGM); \
        BR_ = (fm + ((wgid % nig) % gsz)) * BM; BC_ = ((wgid % nig) / gsz) * BM; } while (0)
    int tile = bid;
    if (tile >= nwg) return;
    int brow, bcol; TILE_RC(tile, brow, bcol);
    f32x4 acc[2][2][4][2];
#pragma unroll
    for (int a = 0; a < 2; ++a)
#pragma unroll
        for (int b = 0; b < 2; ++b)
#pragma unroll
            for (int m = 0; m < 4; ++m)
#pragma unroll
                for (int n = 0; n < 2; ++n) acc[a][b][m][n] = (f32x4){0.f, 0.f, 0.f, 0.f};
    bf16x8 At[4][2]; u32x2 B0[2][2][2], B1[2][2][2];
    const char* cA = (const char*)A + (size_t)brow * lda * 2; const char* cB = (const char*)Bt + (size_t)bcol * 2;
    G_STAGE(G_SB(0, 0), cB, voffB); G_STAGE(G_SB(0, 1), cB + hstepB, voffB); G_STAGE(G_SA(0, 0), cA, voffA); G_STAGE(G_SA(0, 1), cA + hstepA, voffA);
    if (wr == 1) G_BAR;
    G_WAIT_V(2); G_BAR;
    G_STAGE(G_SB(1, 0), cB + kstepB, voffB); G_STAGE(G_SA(1, 0), cA + kstep, voffA); G_STAGE(G_SB(1, 1), cB + hstepB + kstepB, voffB);
    G_WAIT_V(6); G_BAR;
    for (;;) {
        const int ntile = tile + gdim; const bool has_next = ntile < nwg;
        int nbrow = brow, nbcol = bcol; if (has_next) TILE_RC(ntile, nbrow, nbcol);
        const char* nA = has_next ? (const char*)A + (size_t)nbrow * lda * 2 : cA; const char* nB = has_next ? (const char*)Bt + (size_t)nbcol * 2 : cB;
        for (int t = 0; t < nt; t += 2) {
            const bool last = (t == nt - 2);
            const char* a1 = cA + (size_t)(t + 1) * kstep;
            const char* a2 = last ? nA : cA + (size_t)(t + 2) * kstep; const char* b2 = last ? nB : cB + (size_t)(t + 2) * kstepB;
            const char* a3 = a2 + kstep; const char* b3 = b2 + kstepB;
            G_LDB(B0, 0, 0); G_LDB(B1, 0, 1); G_SCHED; G_LDA(At, 0, 0); G_STAGE(G_SA(1, 1), a1 + hstepA, voffA);
            G_WAIT_V(8); G_WAIT_LB(); G_BAR; G_MMA(0, 0, At, B0); G_MMA(0, 1, At, B1); G_BAR; G_SCHED;
            G_LDA(At, 0, 1); G_STAGE(G_SB(0, 0), b2, voffB); G_STAGE(G_SB(0, 1), b2 + hstepB, voffB); G_STAGE(G_SA(0, 0), a2, voffA);
            G_WAIT_V(8); G_WAIT_L(0); G_BAR; G_MMA(1, 0, At, B0); G_MMA(1, 1, At, B1); G_BAR; G_SCHED;
            G_LDB(B0, 1, 0); G_LDB(B1, 1, 1); G_SCHED; G_LDA(At, 1, 0); G_STAGE(G_SA(0, 1), a2 + hstepA, voffA);
            G_WAIT_V(8); G_WAIT_LB(); G_BAR; G_MMA(0, 0, At, B0); G_MMA(0, 1, At, B1); G_BAR; G_SCHED;
            G_LDA(At, 1, 1); G_STAGE(G_SB(1, 0), b3, voffB); G_STAGE(G_SB(1, 1), b3 + hstepB, voffB); G_STAGE(G_SA(1, 0), a3, voffA);
            G_WAIT_V(8); G_WAIT_L(0); G_BAR; G_MMA(1, 0, At, B0); G_MMA(1, 1, At, B1); G_BAR; G_SCHED;
        }
        if (wr == 0) G_BAR;
        { const int t2 = TID(wv); const int l2 = t2 & 63, w2 = t2 >> 6; epi(acc, brow, bcol, w2 >> 2, w2 & 3, l2 & 15, l2 >> 4); }
        if (!has_next) break;
#pragma unroll
        for (int a = 0; a < 2; ++a)
#pragma unroll
            for (int b = 0; b < 2; ++b)
#pragma unroll
                for (int m = 0; m < 4; ++m)
#pragma unroll
                    for (int n = 0; n < 2; ++n) acc[a][b][m][n] = (f32x4){0.f, 0.f, 0.f, 0.f};
        tile = ntile; brow = nbrow; bcol = nbcol; cA = nA; cB = nB;
        if (wr == 1) G_BAR;
    }
    G_WAIT_V(0);
    G_BAR;
}

#define EROW(ai, m) (brow + (ai) * 128 + wr * 64 + (m) * 16 + fr)
#define ECOL(bj, n) (bcol + (bj) * 128 + wc * 32 + (n) * 16 + fq * 4)
typedef unsigned long long sq_t;
DI void sq_add(sq_t* p, float v) { atomicAdd(p, (sq_t)(v * 16777216.0f)); }
DI float sq_get(const sq_t* p) { return (float)(long long)(*p) * (1.0f / 16777216.0f); }
DI sq_t sq_raw(const sq_t* p) { return *p; }
DI float sq_cvt(sq_t v) { return (float)(long long)v * (1.0f / 16777216.0f); }
DI float shx(float v, int mask, int lane) { return __int_as_float(__builtin_amdgcn_ds_bpermute((lane ^ mask) << 2, __float_as_int(v))); }
DI float shx32(float v, int lane) {
    const unsigned u = (unsigned)__float_as_int(v);
    const auto r = __builtin_amdgcn_permlane32_swap(u, u, false, false);
    return __int_as_float((int)((lane & 32) ? r[0] : r[1]));
}
DI float shx16(float v, int lane) {
    const unsigned u = (unsigned)__float_as_int(v);
    const auto r = __builtin_amdgcn_permlane16_swap(u, u, false, false);
    return __int_as_float((int)((lane & 16) ? r[0] : r[1]));
}
DI float red_fq(float v, int lane) { v += shx16(v, lane); v += shx32(v, lane); return v; }
DI float dot4(f32x4 v) { return v[0] * v[0] + v[1] * v[1] + v[2] * v[2] + v[3] * v[3]; }

struct EpiInEven {
    bf16_t* z; const sq_t* sq_in; sq_t* sq_q; sq_t* sq_kv; bf16_t* Kb; const float* cs; const float* sn;
    DI void operator()(f32x4 (&acc)[2][2][4][2], int brow, int bcol, int wr, int wc, int fr, int fq) const {
        sq_t rsq[2][4];
#pragma unroll
        for (int ai = 0; ai < 2; ++ai)
#pragma unroll
            for (int m = 0; m < 4; ++m) rsq[ai][m] = sq_raw(sq_in + EROW(ai, m));
        const bool has_norm = bcol >= 1536;
        const bool rope = (bcol == 2048 && wc == 0);
#pragma unroll
        for (int ai = 0; ai < 2; ++ai) {
            asm volatile("" ::: "memory");
            f32x4 c4v[4], s4v[4];
            if (rope) {
#pragma unroll
                for (int m = 0; m < 4; ++m) { c4v[m] = *(const f32x4*)(cs + (unsigned)EROW(ai, m) * 16 + fq * 4); s4v[m] = *(const f32x4*)(sn + (unsigned)EROW(ai, m) * 16 + fq * 4); }
            }
#pragma unroll
            for (int m = 0; m < 4; ++m) {
                const int row = EROW(ai, m);
                const float rs = rsqrtf(sq_cvt(rsq[ai][m]) * (1.0f / 1024.0f) + EPS);
                float aq = 0.f, akv = 0.f;
#pragma unroll
                for (int bj = 0; bj < 2; ++bj) {
                    const int c32 = bcol + bj * 128 + wc * 32;
                    const f32x4 v0 = acc[ai][bj][m][0] * rs, v1 = acc[ai][bj][m][1] * rs;
                    if (c32 < EV_ZLD) st_bf8_sw(z + (unsigned)row * EV_ZLD + c32, v0, v1, fq);
                    if (has_norm) { const float ss = dot4(v0) + dot4(v1); if (c32 >= 1536 && c32 < 1920) aq += ss; else if (c32 >= 1920 && c32 < 2176) akv += ss; }
                }
                if (has_norm) {
                    aq = red_fq(aq, fq * 16 + fr); akv = red_fq(akv, fq * 16 + fr);
                    if (fq == 0) { if (bcol < 2048) sq_add(sq_q + row, aq); if (bcol >= 1792) sq_add(sq_kv + row, akv); }
                }
                if (rope) {
                    const f32x4 t1 = acc[ai][1][m][0] * rs, t2 = acc[ai][1][m][1] * rs;
                    const f32x4 c4 = c4v[m], s4 = s4v[m];
                    const f32x4 o1 = t1 * c4 - t2 * s4, o2 = t2 * c4 + t1 * s4;
                    const int b = row >> 12, s = row & 4095;
#pragma unroll
                    for (int hh = 0; hh < 8; ++hh) st_bf8_sw(Kb + ((unsigned)(b * 8 + hh) * 4096 + s) * 96 + 64, o1, o2, fq);
                }
            }
        }
    }
};
struct EpiQ {
    bf16_t* Qb; const sq_t* sq; const float* cs; const float* sn;
    DI void operator()(f32x4 (&acc)[2][2][4][2], int brow, int bcol, int wr, int wc, int fr, int fq) const {
        sq_t rsq[2][4];
#pragma unroll
        for (int ai = 0; ai < 2; ++ai)
#pragma unroll
            for (int m = 0; m < 4; ++m) rsq[ai][m] = sq_raw(sq + EROW(ai, m));
        const bool rope0 = ((bcol + wc * 32) % 96) == 64, rope1 = ((bcol + 128 + wc * 32) % 96) == 64;
#pragma unroll
        for (int ai = 0; ai < 2; ++ai) {
            asm volatile("" ::: "memory");
            f32x4 c4v[4], s4v[4];
            if (rope0 || rope1) {
#pragma unroll
                for (int m = 0; m < 4; ++m) { c4v[m] = *(const f32x4*)(cs + (unsigned)EROW(ai, m) * 16 + fq * 4); s4v[m] = *(const f32x4*)(sn + (unsigned)EROW(ai, m) * 16 + fq * 4); }
            }
#pragma unroll
            for (int m = 0; m < 4; ++m) {
                const int row = EROW(ai, m);
                const float rs = rsqrtf(sq_cvt(rsq[ai][m]) * (1.0f / 384.0f) + EPS) * QSCALE;
                const int b = row >> 12, s = row & 4095;
#pragma unroll
                for (int bj = 0; bj < 2; ++bj) {
                    const int c32 = bcol + bj * 128 + wc * 32; const int hh = c32 / 96, d32 = c32 - hh * 96;
                    f32x4 v0 = acc[ai][bj][m][0] * rs, v1 = acc[ai][bj][m][1] * rs;
                    if (d32 == 64) {
                        const f32x4 c4 = c4v[m], s4 = s4v[m];
                        const f32x4 o1 = v0 * c4 - v1 * s4, o2 = v1 * c4 + v0 * s4; v0 = o1; v1 = o2;
                    }
                    st_bf8_sw(Qb + ((unsigned)(b * 8 + hh) * 4096 + s) * 96 + d32, v0, v1, fq);
                }
            }
        }
    }
};
struct EpiKV {
    bf16_t* Kb; bf16_t* Vt; const sq_t* sq;
    DI void operator()(f32x4 (&acc)[2][2][4][2], int brow, int bcol, int wr, int wc, int fr, int fq) const {
        sq_t rsq[2][4];
#pragma unroll
        for (int ai = 0; ai < 2; ++ai)
#pragma unroll
            for (int m = 0; m < 4; ++m) rsq[ai][m] = sq_raw(sq + EROW(ai, m));
#pragma unroll
        for (int ai = 0; ai < 2; ++ai)
#pragma unroll
            for (int m = 0; m < 4; ++m) {
                asm volatile("" ::: "memory");
                const int row = EROW(ai, m);
                const float rs = rsqrtf(sq_cvt(rsq[ai][m]) * (1.0f / 256.0f) + EPS);
                const int b = row >> 12, s = row & 4095;
#pragma unroll
                for (int bj = 0; bj < 2; ++bj) {
                    const int c32 = bcol + bj * 128 + wc * 32; const int hh = c32 >> 7, r32 = c32 & 127;
                    if (r32 < 64) st_bf8_sw(Kb + ((unsigned)(b * 8 + hh) * 4096 + s) * 96 + r32, acc[ai][bj][m][0] * rs, acc[ai][bj][m][1] * rs, fq);
                    else {
#pragma unroll
                        for (int n = 0; n < 2; ++n) {
                            const f32x4 v = acc[ai][bj][m][n] * rs; const int rr = r32 + n * 16 + fq * 4;
                            bf16_t* p = Vt + ((unsigned)(b * 8 + hh) * 64 + (rr - 64)) * 4096 + s; p[0] = f2bf(v[0]); p[4096] = f2bf(v[1]); p[8192] = f2bf(v[2]); p[12288] = f2bf(v[3]);
                        }
                    }
                }
            }
    }
};
struct EpiResid {
    const float* xin; float* xout; bf16_t* xb; sq_t* sq_next; bool wxb;
    DI void operator()(f32x4 (&acc)[2][2][4][2], int brow, int bcol, int wr, int wc, int fr, int fq) const {
#pragma unroll
        for (int ai = 0; ai < 2; ++ai) {
            asm volatile("" ::: "memory");
            f32x4 xv[4][2][2];
#pragma unroll
            for (int m = 0; m < 4; ++m)
#pragma unroll
                for (int bj = 0; bj < 2; ++bj)
#pragma unroll
                    for (int n = 0; n < 2; ++n) xv[m][bj][n] = *(const f32x4*)(xin + (unsigned)EROW(ai, m) * 1024 + ECOL(bj, n));
#pragma unroll
            for (int m = 0; m < 4; ++m) {
                const int row = EROW(ai, m); float ss = 0.f;
#pragma unroll
                for (int bj = 0; bj < 2; ++bj) {
                    const unsigned p0 = (unsigned)row * 1024u + (unsigned)ECOL(bj, 0);
                    const f32x4 v0 = xv[m][bj][0] + acc[ai][bj][m][0], v1 = xv[m][bj][1] + acc[ai][bj][m][1];
                    *(f32x4*)(xout + p0) = v0; *(f32x4*)(xout + p0 + 16) = v1; ss += dot4(v0); ss += dot4(v1);
                    if (wxb) st_bf8_sw(xb + (unsigned)row * 1024u + bcol + bj * 128 + wc * 32, v0, v1, fq);
                }
                ss = red_fq(ss, fq * 16 + fr);
                if (fq == 0) sq_add(sq_next + row, ss);
            }
        }
    }
};
struct EpiMlp1 {
    bf16_t* hid; const sq_t* sq;
    DI void operator()(f32x4 (&acc)[2][2][4][2], int brow, int bcol, int wr, int wc, int fr, int fq) const {
        sq_t rsq[2][4];
#pragma unroll
        for (int ai = 0; ai < 2; ++ai)
#pragma unroll
            for (int m = 0; m < 4; ++m) rsq[ai][m] = sq_raw(sq + EROW(ai, m));
#pragma unroll
        for (int ai = 0; ai < 2; ++ai)
#pragma unroll
            for (int m = 0; m < 4; ++m) {
                asm volatile("" ::: "memory");
                const int row = EROW(ai, m);
                const float rs = rsqrtf(sq_cvt(rsq[ai][m]) * (1.0f / 1024.0f) + EPS);
#pragma unroll
                for (int bj = 0; bj < 2; ++bj) {
                    f32x4 v0 = acc[ai][bj][m][0] * rs, v1 = acc[ai][bj][m][1] * rs;
#pragma unroll
                    for (int e = 0; e < 4; ++e) { const float t0 = fmaxf(v0[e], 0.f), t1 = fmaxf(v1[e], 0.f); v0[e] = t0 * t0; v1[e] = t1 * t1; }
                    st_bf8_sw(hid + (unsigned)row * DFF + bcol + bj * 128 + wc * 32, v0, v1, fq);
                }
            }
    }
};
struct EpiInOdd {
    bf16_t* z; float* glow; const sq_t* sq_in;
    DI void operator()(f32x4 (&acc)[2][2][4][2], int brow, int bcol, int wr, int wc, int fr, int fq) const {
        sq_t rsq[2][4];
#pragma unroll
        for (int ai = 0; ai < 2; ++ai)
#pragma unroll
            for (int m = 0; m < 4; ++m) rsq[ai][m] = sq_raw(sq_in + EROW(ai, m));
#pragma unroll
        for (int ai = 0; ai < 2; ++ai)
#pragma unroll
            for (int m = 0; m < 4; ++m) {
                asm volatile("" ::: "memory");
                const int row = EROW(ai, m);
                const float rs = rsqrtf(sq_cvt(rsq[ai][m]) * (1.0f / 1024.0f) + EPS);
#pragma unroll
                for (int bj = 0; bj < 2; ++bj) {
                    const int c32 = bcol + bj * 128 + wc * 32;
                    if (c32 < OD_ZLD) st_bf8_sw(z + (unsigned)row * OD_ZLD + c32, acc[ai][bj][m][0] * rs, acc[ai][bj][m][1] * rs, fq);
                    else if (c32 == OD_ZLD) *(f32x4*)(glow + (unsigned)row * 16 + fq * 4) = acc[ai][bj][m][0] * rs;
                }
            }
    }
};

DI void conv_weight(int wv, float*  , const float* __restrict__ src, bf16_t* __restrict__ dst, int K, int N, int Npad, const float* __restrict__ g) {
    const int tid = TID(wv); const int bid = BID(), gdim = GDIM();
    const int cpr = Npad / 8, total = K * cpr;
    for (int i = bid * NTHREADS + tid; i < total; i += gdim * NTHREADS) {
        const int k = i / cpr, c8 = (i - k * cpr) * 8;
        u32x4 w = (u32x4){0u, 0u, 0u, 0u};
        if (c8 < N) {
            const f32x4 a = *(const f32x4*)(src + (size_t)k * N + c8), b = *(const f32x4*)(src + (size_t)k * N + c8 + 4);
            const float gg = g ? g[k] : 1.0f;
            w.x = pk2(a[0] * gg, a[1] * gg); w.y = pk2(a[2] * gg, a[3] * gg); w.z = pk2(b[0] * gg, b[1] * gg); w.w = pk2(b[2] * gg, b[3] * gg);
        }
        *(u32x4*)(dst + (size_t)k * Npad + c8) = w;
    }
}

typedef const __attribute__((address_space(4))) Params* KP;
DI void prologue(int wv, KP pp, unsigned char* ws, unsigned char* smem) {
    float* tile = (float*)smem;
    const int tid = TID(wv), wid = tid >> 6, lane = tid & 63; const int bid = BID(), gdim = GDIM();
    sq_t* sq = (sq_t*)(ws + OFF_SQ);
    for (size_t i = (size_t)bid * NTHREADS + tid; i < SQ_FLOATS - R; i += (size_t)gdim * NTHREADS) sq[R + i] = 0ull;
    bf16_t* xb = (bf16_t*)(ws + OFF_XB);
    for (int row = bid * 8 + wid; row < R; row += gdim * 8) {
        float ss = 0.f;
#pragma unroll
        for (int i = 0; i < 4; ++i) {
            const size_t o = (size_t)row * 1024 + i * 256 + lane * 4;
            const f32x4 v = *(const f32x4*)(pp->x + o); ss += dot4(v); st_bf4(xb + o, v);
            if (XCOPY) *(f32x4*)(pp->out + o) = v;
        }
#pragma unroll
        for (int d = 1; d < 64; d <<= 1) ss += shx(ss, d, lane);
        if (lane == 0) sq[row] = (sq_t)(ss * 16777216.0f);
    }
    float* cs = (float*)(ws + OFF_COS); float* sn = (float*)(ws + OFF_SIN);
    for (int i = bid * NTHREADS + tid; i < R * 16; i += gdim * NTHREADS) {
        const int row = i >> 4, f = i & 15;
        const float inv_freq = 1.0f / powf(10000.0f, (float)(2 * f) / 32.0f);
        const float ang = (float)pp->pos[row] * inv_freq;
        const double a = (double)ang;
        const double kq = rint(a * 0.63661977236758134308);
        const double rr = a - kq * 1.57079632679489661923;
        const double r2 = rr * rr;
        const double sp = rr * (1.0 + r2 * (-1.0 / 6 + r2 * (1.0 / 120 + r2 * (-1.0 / 5040 + r2 * (1.0 / 362880 + r2 * (-1.0 / 39916800 + r2 * (1.0 / 6227020800.0)))))));
        const double cp = 1.0 + r2 * (-0.5 + r2 * (1.0 / 24 + r2 * (-1.0 / 720 + r2 * (1.0 / 40320 + r2 * (-1.0 / 3628800 + r2 * (1.0 / 479001600.0 + r2 * (-1.0 / 87178291200.0)))))));
        const int q = ((int)kq) & 3;
        const double sv = (q == 0) ? sp : (q == 1) ? cp : (q == 2) ? -sp : -cp;
        const double cv = (q == 0) ? cp : (q == 1) ? -sp : (q == 2) ? -cp : sp;
        cs[i] = (float)cv; sn[i] = (float)sv;
    }
    for (int j = 0; j < 2; ++j) {
        conv_weight(wv, tile, pp->ev_w_in + (size_t)j * 1024 * EV_IN, (bf16_t*)(ws + WT_EVIN) + (size_t)j * EV_IN_PAD * 1024, 1024, EV_IN, EV_IN_PAD, pp->mix_g + (2 * j) * 1024);
        conv_weight(wv, tile, pp->ev_wqb + (size_t)j * 384 * 768, (bf16_t*)(ws + WT_EVQ) + (size_t)j * 768 * 384, 384, 768, 768, pp->ev_qg + j * 384);
        conv_weight(wv, tile, pp->ev_wkvb + (size_t)j * 256 * 1024, (bf16_t*)(ws + WT_EVKV) + (size_t)j * 1024 * 256, 256, 1024, 1024, pp->ev_kvg + j * 256);
        conv_weight(wv, tile, pp->ev_wout + (size_t)j * 1024 * 1024, (bf16_t*)(ws + WT_EVOUT) + (size_t)j * 1024 * 1024, 1024, 1024, 1024, nullptr);
        conv_weight(wv, tile, pp->od_w_in + (size_t)j * 1024 * OD_IN, (bf16_t*)(ws + WT_ODIN) + (size_t)j * OD_IN_PAD * 1024, 1024, OD_IN, OD_IN_PAD, pp->mix_g + (2 * j + 1) * 1024);
        conv_weight(wv, tile, pp->od_wout + (size_t)j * 1024 * 1024, (bf16_t*)(ws + WT_ODOUT) + (size_t)j * 1024 * 1024, 1024, 1024, 1024, nullptr);
    }
    for (int L = 0; L < 4; ++L) {
        conv_weight(wv, tile, pp->w1 + (size_t)L * 1024 * 4096, (bf16_t*)(ws + WT_W1) + (size_t)L * 4096 * 1024, 1024, 4096, 4096, pp->mlp_g + L * 1024);
        conv_weight(wv, tile, pp->w2 + (size_t)L * 4096 * 1024, (bf16_t*)(ws + WT_W2) + (size_t)L * 1024 * 4096, 4096, 1024, 1024, nullptr);
    }
}

DI void conv_phase(int wv, const bf16_t* __restrict__ z, const float* __restrict__ cw  , bf16_t* __restrict__ mix) {
    const int tid0 = TID(wv); const int bid = BID(), gdim = GDIM();
    for (int i = bid * NTHREADS + tid0; i < R * 64; i += gdim * NTHREADS) {
        const int row = i >> 6, c8 = (i & 63) * 8, s = row & 4095;
        const bf16_t* zr = z + (size_t)row * EV_ZLD;
        const u32x4 ab = *(const u32x4*)(zr + c8);
        float u[3][8];
#pragma unroll
        for (int k = 0; k < 3; ++k) {
            const int back = 2 - k;
            if (s >= back) {
                const u32x4 ac = *(const u32x4*)(zr - (size_t)back * EV_ZLD + 512 + c8), av = *(const u32x4*)(zr - (size_t)back * EV_ZLD + 1024 + c8);
#pragma unroll
                for (int e = 0; e < 4; ++e) { u[k][2 * e] = bflo(ac[e]) * bflo(av[e]); u[k][2 * e + 1] = bfhi(ac[e]) * bfhi(av[e]); }
            } else {
#pragma unroll
                for (int e = 0; e < 8; ++e) u[k][e] = 0.f;
            }
        }
        float y[8];
#pragma unroll
        for (int e = 0; e < 8; ++e) {
            const float conv = cw[c8 + e] * u[0][e] + cw[512 + c8 + e] * u[1][e] + cw[1024 + c8 + e] * u[2][e];
            const float abv = (e & 1) ? bfhi(ab[e >> 1]) : bflo(ab[e >> 1]);
            y[e] = abv * conv;
        }
        u32x4 w; w.x = pk2(y[0], y[1]); w.y = pk2(y[2], y[3]); w.z = pk2(y[4], y[5]); w.w = pk2(y[6], y[7]);
        *(u32x4*)(mix + (size_t)row * 1024 + c8) = w;
    }
}

DI void attn_phase(int wv, unsigned char* smem, const bf16_t* __restrict__ Qb, const bf16_t* __restrict__ Kb, const bf16_t* __restrict__ Vt, bf16_t* __restrict__ mix) {
    constexpr int KROW = 208, VROW = 136, KBUF = 64 * KROW, VBUF = 64 * VROW, BUF = KBUF + VBUF;
    const int tid = TID(wv), wid = tid >> 6, lane = tid & 63, r = lane & 31, h = lane >> 5; const int bid = BID(), gdim = GDIM();
    for (int item = bid; item < 512; item += gdim) {
        const int pp = (item >> 3) & 7, bh = (item & 7) + 8 * ((item >> 6) & 3) + 32 * (item >> 8);
        const unsigned char* Kg = (const unsigned char*)(Kb + (size_t)bh * 4096 * 96);
        const unsigned char* Vg = (const unsigned char*)(Vt + (size_t)bh * 64 * 4096);
        for (int half = 0; half < 2; ++half) {
            const int qb = half ? 15 - pp : pp;
            const int q0 = qb * 256 + wid * 32;
            const bf16_t* Qp = Qb + ((size_t)bh * 4096 + q0 + r) * 96;
            bf16x8 qf[6];
#pragma unroll
            for (int ks = 0; ks < 6; ++ks) qf[ks] = *(const bf16x8*)(Qp + 16 * ks + 8 * h);
            asm volatile("s_waitcnt vmcnt(0)" : "+v"(qf[0]), "+v"(qf[1]), "+v"(qf[2]), "+v"(qf[3]), "+v"(qf[4]), "+v"(qf[5]) :: "memory");
            f32x16 o0, o1;
#pragma unroll
            for (int i = 0; i < 16; ++i) { o0[i] = 0.f; o1[i] = 0.f; }
            float mrun = -INFINITY, lrun = 0.f;
            const int nt = 4 * (qb + 1);
            __syncthreads();
            {
                const u32x4 k0v = *(const u32x4*)(Kg + tid * 16);
                u32x4 k1v; if (tid < 256) k1v = *(const u32x4*)(Kg + (tid + 512) * 16);
                const u32x4 vv = *(const u32x4*)(Vg + (size_t)(tid >> 3) * 8192 + (tid & 7) * 16);
                *(u32x4*)(smem + (tid / 12) * KROW + (tid % 12) * 16) = k0v;
                if (tid < 256) *(u32x4*)(smem + ((tid + 512) / 12) * KROW + ((tid + 512) % 12) * 16) = k1v;
                unsigned char* vd = smem + KBUF + (tid >> 3) * VROW + (tid & 7) * 16;
                *(u32x2*)vd = (u32x2){vv.x, vv.y}; *(u32x2*)(vd + 8) = (u32x2){vv.z, vv.w};
            }
            __syncthreads();
            for (int kt = 0; kt < nt; ++kt) {
                const bool more = kt + 1 < nt;
                u32x4 k0v, k1v, vv;
                if (more) {
                    const unsigned char* kg = Kg + (size_t)(kt + 1) * 12288;
                    k0v = *(const u32x4*)(kg + tid * 16);
                    if (tid < 256) k1v = *(const u32x4*)(kg + (tid + 512) * 16);
                    vv = *(const u32x4*)(Vg + (size_t)(tid >> 3) * 8192 + (kt + 1) * 128 + (tid & 7) * 16);
                }
                const unsigned char* kb_ = smem + (kt & 1) * BUF; const unsigned char* vb_ = kb_ + KBUF;
                const int key0 = kt * 64;
                if (key0 <= q0 + 31) {
                    f32x16 s0, s1;
#pragma unroll
                    for (int i = 0; i < 16; ++i) { s0[i] = 0.f; s1[i] = 0.f; }
                    bf16x8 ka0[6], ka1[6];
#pragma unroll
                    for (int ks = 0; ks < 6; ++ks) { ka0[ks] = *(const bf16x8*)(kb_ + r * KROW + ks * 32 + h * 16); ka1[ks] = *(const bf16x8*)(kb_ + (32 + r) * KROW + ks * 32 + h * 16); }
                    __builtin_amdgcn_sched_barrier(0);
#pragma unroll
                    for (int ks = 0; ks < 6; ++ks) { s0 = MFMA32(ka0[ks], qf[ks], s0); s1 = MFMA32(ka1[ks], qf[ks], s1); }
                    if (key0 + 63 > q0) {
                        const int qpos = q0 + r;
#pragma unroll
                        for (int i = 0; i < 16; ++i) { const int key = key0 + crow(i, h); if (key > qpos) s0[i] = -INFINITY; if (key + 32 > qpos) s1[i] = -INFINITY; }
                    }
                    float mx = s0[0];
#pragma unroll
                    for (int i = 1; i < 16; ++i) mx = fmaxf(mx, s0[i]);
#pragma unroll
                    for (int i = 0; i < 16; ++i) mx = fmaxf(mx, s1[i]);
                    mx = fmaxf(mx, shx32(mx, lane));
                    const float mnew = fmaxf(mrun, mx);
                    const float alpha = __builtin_amdgcn_exp2f(mrun - mnew);
                    float ls = 0.f;
#pragma unroll
                    for (int i = 0; i < 16; ++i) { s0[i] = __builtin_amdgcn_exp2f(s0[i] - mnew); s1[i] = __builtin_amdgcn_exp2f(s1[i] - mnew); ls += s0[i] + s1[i]; }
                    lrun = lrun * alpha + ls; mrun = mnew;
#pragma unroll
                    for (int i = 0; i < 16; ++i) { o0[i] *= alpha; o1[i] *= alpha; }
                    bf16x8 pf[4];
                    pf[0] = pack8(s0, 0); pf[1] = pack8(s0, 1); pf[2] = pack8(s1, 0); pf[3] = pack8(s1, 1);
                    bf16x8 va0[4], va1[4];
#pragma unroll
                    for (int kk = 0; kk < 4; ++kk) {
                        const int koff = (kk >> 1) * 32 + (kk & 1) * 16 + 4 * h;
                        const s16x4 lo0 = *(const s16x4*)(vb_ + r * VROW + koff * 2), hi0 = *(const s16x4*)(vb_ + r * VROW + (koff + 8) * 2);
                        const s16x4 lo1 = *(const s16x4*)(vb_ + (32 + r) * VROW + koff * 2), hi1 = *(const s16x4*)(vb_ + (32 + r) * VROW + (koff + 8) * 2);
                        va0[kk] = __builtin_shufflevector(lo0, hi0, 0, 1, 2, 3, 4, 5, 6, 7);
                        va1[kk] = __builtin_shufflevector(lo1, hi1, 0, 1, 2, 3, 4, 5, 6, 7);
                    }
                    __builtin_amdgcn_sched_barrier(0);
#pragma unroll
                    for (int kk = 0; kk < 4; ++kk) { o0 = MFMA32(va0[kk], pf[kk], o0); o1 = MFMA32(va1[kk], pf[kk], o1); }
                }
                if (more) {
                    unsigned char* nb = smem + ((kt + 1) & 1) * BUF;
                    *(u32x4*)(nb + (tid / 12) * KROW + (tid % 12) * 16) = k0v;
                    if (tid < 256) *(u32x4*)(nb + ((tid + 512) / 12) * KROW + ((tid + 512) % 12) * 16) = k1v;
                    unsigned char* vd = nb + KBUF + (tid >> 3) * VROW + (tid & 7) * 16;
                    *(u32x2*)vd = (u32x2){vv.x, vv.y}; *(u32x2*)(vd + 8) = (u32x2){vv.z, vv.w};
                }
                __syncthreads();
            }
            lrun += shx32(lrun, lane);
            const float inv = 1.0f / lrun;
            const int b = bh >> 3, head = bh & 7;
            bf16_t* op = mix + ((size_t)b * 4096 + q0 + r) * 1024 + 512 + head * 64;
#pragma unroll
            for (int g = 0; g < 4; g += 2) {
                st_bf8_sw32(op + 8 * g, (f32x4){o0[4 * g] * inv, o0[4 * g + 1] * inv, o0[4 * g + 2] * inv, o0[4 * g + 3] * inv},
                            (f32x4){o0[4 * g + 4] * inv, o0[4 * g + 5] * inv, o0[4 * g + 6] * inv, o0[4 * g + 7] * inv}, h);
                st_bf8_sw32(op + 32 + 8 * g, (f32x4){o1[4 * g] * inv, o1[4 * g + 1] * inv, o1[4 * g + 2] * inv, o1[4 * g + 3] * inv},
                            (f32x4){o1[4 * g + 4] * inv, o1[4 * g + 5] * inv, o1[4 * g + 6] * inv, o1[4 * g + 7] * inv}, h);
            }
        }
    }
}

DI void gla_prep(int wv, bool dry, unsigned char* smem, bf16_t* __restrict__ z, const float* __restrict__ glow, const float* __restrict__ wg2, const float* __restrict__ bg2,
                 bf16_t* __restrict__ KLT, bf16_t* __restrict__ AT, float* __restrict__ DEC) {
    float* s_glow = (float*)smem;
    float* s_seg = (float*)(smem + 4096);
    unsigned char* s_qe = smem + 8192;
    unsigned char* s_ke = s_qe + 64 * 272;
    const int tid = TID(wv), wid = tid >> 6, lane = tid & 63, r = lane & 31, h = lane >> 5; const int bid = BID(), gdim = GDIM();
    const int dk = tid & 127, tq = tid >> 7;
    f32x4 gpre = (f32x4){0.f, 0.f, 0.f, 0.f};
    if (bid < 2048 && tid < 256) gpre = ((const f32x4*)(glow + ((size_t)(bid >> 8) * 4096 + (bid & 63) * 64) * 16))[tid];
    for (int item = bid; item < 2048; item += gdim) {
        const int n = item & 63, hh = (item >> 6) & 3, b = item >> 8;
        const size_t row0 = (size_t)b * 4096 + n * 64;
        bf16_t qraw[16], kraw[16];
#pragma unroll
        for (int tt = 0; tt < 16; ++tt) { const bf16_t* zr = z + (row0 + tq * 16 + tt) * OD_ZLD + hh * 128 + dk; qraw[tt] = zr[0]; kraw[tt] = zr[512]; }
        __syncthreads();
        if (tid < 256) {
            ((f32x4*)s_glow)[tid] = gpre;
            const int nitem = item + gdim;
            if (nitem < 2048) gpre = ((const f32x4*)(glow + ((size_t)(nitem >> 8) * 4096 + (nitem & 63) * 64) * 16))[tid];
        }
        float w[16];
#pragma unroll
        for (int j = 0; j < 16; ++j) w[j] = wg2[j * 512 + hh * 128 + dk];
        const float bb = bg2[hh * 128 + dk];
        __syncthreads();
        float la[16]; float run = 0.f;
#pragma unroll
        for (int tt = 0; tt < 16; ++tt) {
            const int t = tq * 16 + tt; float xg = bb;
#pragma unroll
            for (int j = 0; j < 16; ++j) xg += s_glow[t * 16 + j] * w[j];
            const float ls = fminf(xg, 0.f) - 0.6931471805599453f * __builtin_amdgcn_logf(1.0f + __expf(-fabsf(xg)));
            run += ls * (1.0f / 16.0f); la[tt] = run;
        }
        s_seg[tq * 128 + dk] = run;
        __syncthreads();
        float pre = 0.f, tot = 0.f;
#pragma unroll
        for (int s = 0; s < 4; ++s) { const float v = s_seg[s * 128 + dk]; if (s < tq) pre += v; tot += v; }
        unsigned klp[8];
        const float etot = __expf(tot);
#pragma unroll
        for (int tt = 0; tt < 16; tt += 2) {
            float klv[2];
#pragma unroll
            for (int e = 0; e < 2; ++e) {
                const int t = tq * 16 + tt + e; const float bc = pre + la[tt + e];
                bf16_t* zr = z + (row0 + t) * OD_ZLD + hh * 128 + dk;
                const float q = bf2f(qraw[tt + e]), k = bf2f(kraw[tt + e]);
                const float e1 = __expf(bc), e2 = __builtin_amdgcn_rcpf(e1);
                const bf16_t qe = f2bf(q * GLA_QSCALE * e1), ke = f2bf(k * e2);
                klv[e] = k * (etot * e2);
                if (!dry) zr[0] = qe;
                *(bf16_t*)(s_qe + t * 272 + dk * 2) = qe; *(bf16_t*)(s_ke + t * 272 + dk * 2) = ke;
            }
            klp[tt >> 1] = pk2(klv[0], klv[1]);
        }
        {
            u32x4* kd = (u32x4*)(KLT + ((size_t)item * 128 + dk) * 64 + tq * 16);
            if (!dry) { kd[0] = (u32x4){klp[0], klp[1], klp[2], klp[3]}; kd[1] = (u32x4){klp[4], klp[5], klp[6], klp[7]}; }
        }
        if (tq == 0 && !dry) DEC[(size_t)item * 128 + dk] = etot;
        __syncthreads();
        if (wid < 3) {
            const int jb = (wid == 2), ib = (wid >= 1);
            f32x16 acc;
#pragma unroll
            for (int i = 0; i < 16; ++i) acc[i] = 0.f;
            bf16x8 pa[8], pb[8];
#pragma unroll
            for (int ks = 0; ks < 8; ++ks) { pa[ks] = *(const bf16x8*)(s_ke + (jb * 32 + r) * 272 + ks * 32 + h * 16); pb[ks] = *(const bf16x8*)(s_qe + (ib * 32 + r) * 272 + ks * 32 + h * 16); }
            __builtin_amdgcn_sched_barrier(0);
#pragma unroll
            for (int ks = 0; ks < 8; ++ks) acc = MFMA32(pa[ks], pb[ks], acc);
            const int i_tok = ib * 32 + r;
#pragma unroll
            for (int g = 0; g < 4; g += 2) {
                f32x4 v, v2;
#pragma unroll
                for (int e = 0; e < 4; ++e) { const int j = jb * 32 + 8 * g + 4 * h + e; v[e] = (j <= i_tok) ? acc[4 * g + e] : 0.f; v2[e] = (j + 8 <= i_tok) ? acc[4 * g + 4 + e] : 0.f; }
                if (!dry) st_bf8_sw32(AT + ((size_t)item * 64 + i_tok) * 64 + jb * 32 + 8 * g, v, v2, h);
            }
        } else if (wid == 3) {
#pragma unroll
            for (int g = 0; g < 4; ++g) if (!dry) *(u32x2*)(AT + ((size_t)item * 64 + r) * 64 + 32 + 8 * g + 4 * h) = (u32x2){0u, 0u};
        }
    }
}

DI void gla_scan(int wv, bool dry, unsigned char* smem, bf16_t* __restrict__ z, const bf16_t* __restrict__ KLT, const bf16_t* __restrict__ AT, const float* __restrict__ DEC, sq_t* __restrict__ sq_o) {
    constexpr int QE_OFF = 0, KL_OFF = 17408, AT_OFF = KL_OFF + 18432, VT_OFF = AT_OFF + 9216, DEC_OFF = VT_OFF + 4608, BUF = DEC_OFF + 512;
    constexpr int ST_OFF = 2 * BUF, ST_SZ = 32 * 272;
    const int tid = TID(wv), wid = tid >> 6, lane = tid & 63, r = lane & 31, h = lane >> 5; const int bid = BID(), gdim = GDIM();
    for (int item = bid; item < 256; item += gdim) {
        const int dvs = (item >> 3) & 7, gbh = (item & 7) + 8 * (item >> 6), hh = gbh & 3, b = gbh >> 2;
        const size_t ci0 = (size_t)(b * 4 + hh) * 64;
        f32x16 S;
#pragma unroll
        for (int i = 0; i < 16; ++i) S[i] = 0.f;
        __syncthreads();
        for (int i = tid; i < ST_SZ / 4; i += NTHREADS) ((unsigned*)(smem + ST_OFF))[i] = 0u;
#define GLA_DECL(P) u32x4 P##q0, P##q1, P##k0, P##k1, P##a; u32x2 P##v; float P##d = 0.f;
#define GLA_LOAD(P, n_) do { const size_t ci = ci0 + (n_); const size_t row0 = (size_t)b * 4096 + (size_t)(n_) * 64; \
            P##q0 = *(const u32x4*)(z + (row0 + (tid >> 4)) * OD_ZLD + hh * 128 + (tid & 15) * 8); \
            P##q1 = *(const u32x4*)(z + (row0 + 32 + (tid >> 4)) * OD_ZLD + hh * 128 + (tid & 15) * 8); \
            P##k0 = *(const u32x4*)(KLT + ci * 8192 + (size_t)tid * 8); P##k1 = *(const u32x4*)(KLT + ci * 8192 + (size_t)(tid + 512) * 8); \
            P##a = *(const u32x4*)(AT + ci * 4096 + (size_t)tid * 8); \
            P##v = *(const u32x2*)(z + (row0 + (tid >> 3)) * OD_ZLD + 1024 + hh * 256 + dvs * 32 + (tid & 7) * 4); \
            if (tid < 128) P##d = DEC[ci * 128 + tid]; } while (0)
#define GLA_STORE(P, bufp) do { unsigned char* bp_ = (bufp); \
            *(u32x4*)(bp_ + QE_OFF + (tid >> 4) * 272 + (tid & 15) * 16) = P##q0; *(u32x4*)(bp_ + QE_OFF + (32 + (tid >> 4)) * 272 + (tid & 15) * 16) = P##q1; \
            *(u32x4*)(bp_ + KL_OFF + (tid >> 3) * 144 + (tid & 7) * 16) = P##k0; *(u32x4*)(bp_ + KL_OFF + (64 + (tid >> 3)) * 144 + (tid & 7) * 16) = P##k1; \
            *(u32x4*)(bp_ + AT_OFF + (tid >> 3) * 144 + (tid & 7) * 16) = P##a; \
            { const int t_ = tid >> 3, d_ = (tid & 7) * 4; bf16_t* vt_ = (bf16_t*)(bp_ + VT_OFF) + t_; \
              vt_[(d_ + 0) * 72] = (bf16_t)(P##v.x & 0xffffu); vt_[(d_ + 1) * 72] = (bf16_t)(P##v.x >> 16); vt_[(d_ + 2) * 72] = (bf16_t)(P##v.y & 0xffffu); vt_[(d_ + 3) * 72] = (bf16_t)(P##v.y >> 16); } \
            if (tid < 128) ((float*)(bp_ + DEC_OFF))[tid] = P##d; } while (0)
#define GLA_COMPUTE(n_) do { \
            const unsigned char* bp = smem + ((n_) & 1) * BUF; \
            const unsigned char* stc = smem + ST_OFF + ((n_) & 1) * ST_SZ; \
            unsigned char* stn = smem + ST_OFF + (((n_) + 1) & 1) * ST_SZ; \
            if (wid < 4) { \
                const int dkb = wid; \
                const float* dec = (const float*)(bp + DEC_OFF) + dkb * 32; \
                _Pragma("unroll") for (int i = 0; i < 16; ++i) S[i] *= dec[crow(i, h)]; \
                bf16x8 sa[4], sb[4]; \
                _Pragma("unroll") for (int ks = 0; ks < 4; ++ks) { \
                    sa[ks] = *(const bf16x8*)(bp + KL_OFF + (dkb * 32 + r) * 144 + ks * 32 + h * 16); \
                    sb[ks] = *(const bf16x8*)(bp + VT_OFF + r * 144 + ks * 32 + h * 16); } \
                __builtin_amdgcn_sched_barrier(0); \
                _Pragma("unroll") for (int ks = 0; ks < 4; ++ks) S = MFMA32(sa[ks], sb[ks], S); \
                _Pragma("unroll") for (int g = 0; g < 4; ++g) { \
                    u32x2 wv_; wv_.x = pk2(S[4 * g], S[4 * g + 1]); wv_.y = pk2(S[4 * g + 2], S[4 * g + 3]); \
                    *(u32x2*)(stn + r * 272 + (dkb * 32 + 8 * g + 4 * h) * 2) = wv_; } \
            } else if (wid < 6) { \
                const int ib = wid - 4; \
                f32x16 acc; \
                _Pragma("unroll") for (int i = 0; i < 16; ++i) acc[i] = 0.f; \
                bf16x8 oa[12], ob[12];        \
                _Pragma("unroll") for (int ks = 0; ks < 4; ++ks) { \
                    oa[ks] = *(const bf16x8*)(bp + VT_OFF + r * 144 + ks * 32 + h * 16); \
                    ob[ks] = *(const bf16x8*)(bp + AT_OFF + (ib * 32 + r) * 144 + ks * 32 + h * 16); } \
                _Pragma("unroll") for (int ks = 0; ks < 8; ++ks) { \
                    oa[4 + ks] = *(const bf16x8*)(stc + r * 272 + ks * 32 + h * 16); \
                    ob[4 + ks] = *(const bf16x8*)(bp + QE_OFF + (ib * 32 + r) * 272 + ks * 32 + h * 16); } \
                __builtin_amdgcn_sched_barrier(0); \
                _Pragma("unroll") for (int ks = 0; ks < 12; ++ks) acc = MFMA32(oa[ks], ob[ks], acc); \
                const size_t row = (size_t)b * 4096 + (size_t)(n_) * 64 + ib * 32 + r; \
                bf16_t* op = z + row * OD_ZLD + 1024 + hh * 256 + dvs * 32; \
                float ss = 0.f; \
                _Pragma("unroll") for (int g = 0; g < 4; g += 2) { \
                    const f32x4 v = (f32x4){acc[4 * g], acc[4 * g + 1], acc[4 * g + 2], acc[4 * g + 3]}; \
                    const f32x4 v2 = (f32x4){acc[4 * g + 4], acc[4 * g + 5], acc[4 * g + 6], acc[4 * g + 7]}; \
                    ss += dot4(v); ss += dot4(v2); if (!dry) st_bf8_sw32(op + 8 * g, v, v2, h); } \
                ss += shx32(ss, lane); \
                if (h == 0 && !dry) sq_add(sq_o + row * 4 + hh, ss); \
            } } while (0)
        GLA_DECL(ra) GLA_DECL(rb)
        GLA_LOAD(ra, 0);
        GLA_STORE(ra, smem);
        GLA_LOAD(ra, 1); GLA_LOAD(rb, 2);
        __syncthreads();
#pragma unroll 1
        for (int n = 0; n < 64; n += 2) {
            GLA_COMPUTE(n);
            GLA_STORE(ra, smem + ((n + 1) & 1) * BUF);
            if (n + 3 < 64) GLA_LOAD(ra, n + 3);
            __syncthreads();
            GLA_COMPUTE(n + 1);
            if (n + 2 < 64) GLA_STORE(rb, smem + (n & 1) * BUF);
            if (n + 4 < 64) GLA_LOAD(rb, n + 4);
            __syncthreads();
        }
    }
#undef GLA_DECL
#undef GLA_LOAD
#undef GLA_STORE
#undef GLA_COMPUTE
}

DI void gla_gate(int wv, const bf16_t* __restrict__ z, const sq_t* __restrict__ sq_o, const float* __restrict__ og, bf16_t* __restrict__ mix) {
    const int tid0 = TID(wv); const int bid = BID(), gdim = GDIM();
    for (int i = bid * NTHREADS + tid0; i < R * 128; i += gdim * NTHREADS) {
        const int row = i >> 7, c8 = (i & 127) * 8, hh = c8 >> 8;
        const float rs = rsqrtf(sq_get(sq_o + (size_t)row * 4 + hh) * (1.0f / 256.0f) + EPS);
        const u32x4 o8 = *(const u32x4*)(z + (size_t)row * OD_ZLD + 1024 + c8), g8 = *(const u32x4*)(z + (size_t)row * OD_ZLD + 2048 + c8);
        float y[8];
#pragma unroll
        for (int e = 0; e < 8; ++e) {
            const float o = (e & 1) ? bfhi(o8[e >> 1]) : bflo(o8[e >> 1]);
            const float g = (e & 1) ? bfhi(g8[e >> 1]) : bflo(g8[e >> 1]);
            y[e] = o * rs * og[(c8 & 255) + e] * (g / (1.0f + __expf(-g)));
        }
        u32x4 w; w.x = pk2(y[0], y[1]); w.y = pk2(y[2], y[3]); w.z = pk2(y[4], y[5]); w.w = pk2(y[6], y[7]);
        *(u32x4*)(mix + (size_t)row * 1024 + c8) = w;
    }
}

DI void final_phase(int wv, float* __restrict__ out, const sq_t* __restrict__ sq, const float* __restrict__ g) {
    const int tid0 = TID(wv); const int bid = BID(), gdim = GDIM();
    for (int i = bid * NTHREADS + tid0; i < R * 256; i += gdim * NTHREADS) {
        const int row = i >> 8, c4 = (i & 255) * 4;
        const float rs = rsqrtf(sq_get(sq + row) * (1.0f / 1024.0f) + EPS);
        f32x4 v = *(const f32x4*)(out + (size_t)row * 1024 + c4);
        const f32x4 gg = *(const f32x4*)(g + c4);
        v = v * rs * gg;
        *(f32x4*)(out + (size_t)row * 1024 + c4) = v;
    }
}

#define XB_TMO      128
#define XB_XCNT(j)  (256  + 64 * (j))
#define XB_XSUB(j)  (1280 + 64 * (j))
#define XB_XGEN(j)  (2304 + 64 * (j))
#define XB_TOP      3328
#define XB_TOPGEN   3392
#define XCD_BAR_WORDS 3456
#define XB_SPIN_CAP (1u << 18)
DI unsigned xb_ld(unsigned* p) { return __hip_atomic_load(p, __ATOMIC_RELAXED, __HIP_MEMORY_SCOPE_AGENT); }
DI unsigned xb_add(unsigned* p, unsigned v) { return __hip_atomic_fetch_add(p, v, __ATOMIC_RELAXED, __HIP_MEMORY_SCOPE_AGENT); }
DI unsigned xb_xcc_id() { return (unsigned)__builtin_amdgcn_s_getreg((3 << 11) | 20) & 0xFu; }
#define XB_SPIN(cond, bar) do { unsigned _sp = 0; while (cond) { __builtin_amdgcn_s_sleep(1); \
    if ((++_sp & 255u) == 0u) { if (xb_ld(&(bar)[XB_TMO])) break; if (_sp > XB_SPIN_CAP) { atomicAdd(&(bar)[XB_TMO], 1u); break; } } } } while (0)
DI void xcd_barrier_complete(unsigned* bar, unsigned x, unsigned& nloc, unsigned& nx) {
    const unsigned G = gridDim.x;
    unsigned sum, cnt, mine, sp = 0u;
    for (;;) {
        sum = 0u; cnt = 0u; mine = 0u;
#pragma unroll
        for (unsigned j = 0; j < 16; ++j) { const unsigned c = xb_ld(&bar[XB_XCNT(j)]); sum += c; cnt += (c > 0u) ? 1u : 0u; mine = (j == x) ? c : mine; }
        if (sum == G) break;
        __builtin_amdgcn_s_sleep(1);
        if ((++sp & 255u) == 0u) { if (xb_ld(&bar[XB_TMO])) break; if (sp > XB_SPIN_CAP) { atomicAdd(&bar[XB_TMO], 1u); break; } }
    }
    nloc = mine > 0u ? mine : 1u; nx = cnt > 0u ? cnt : 1u;
}
DI void xcd_barrier(unsigned* bar, volatile LAS unsigned* st, int tid) {
    asm volatile("s_waitcnt vmcnt(0) lgkmcnt(0)" ::: "memory");
    __syncthreads();
    if (tid == 0) {
        __builtin_amdgcn_s_waitcnt(0);
        const unsigned x = xb_xcc_id();
        unsigned nloc = st[0], nx = st[1];
        if (nloc == 0u) { xcd_barrier_complete(bar, x, nloc, nx); st[0] = nloc; st[1] = nx; }
        const unsigned old = xb_add(&bar[XB_XSUB(x)], 1u);
        const unsigned gen = old / nloc;
        if (old + 1u == (gen + 1u) * nloc) {
            __builtin_amdgcn_fence(__ATOMIC_RELEASE, "agent");
            asm volatile("s_waitcnt vmcnt(0)" ::: "memory");
            const unsigned og = xb_add(&bar[XB_TOP], 1u);
            const unsigned tg = og / nx;
            if (og + 1u == (tg + 1u) * nx) xb_add(&bar[XB_TOPGEN], 1u);
            else XB_SPIN(xb_ld(&bar[XB_TOPGEN]) == tg, bar);
            __builtin_amdgcn_fence(__ATOMIC_ACQUIRE, "agent");
            xb_add(&bar[XB_XGEN(x)], 1u);
            asm volatile("s_waitcnt vmcnt(0)" ::: "memory");
        } else {
            XB_SPIN(xb_ld(&bar[XB_XGEN(x)]) == gen, bar);
            __builtin_amdgcn_fence(__ATOMIC_ACQUIRE, "agent");
            asm volatile("s_waitcnt vmcnt(0)" ::: "memory");
        }
    }
    __syncthreads();
}

__global__ void __launch_bounds__(NTHREADS, 2) mega(Params p) {
    extern __shared__ __attribute__((aligned(16))) unsigned char smem[];
    cg::grid_group grid = cg::this_grid();
    const int wv = __builtin_amdgcn_readfirstlane((int)(threadIdx.x >> 6));
    KP kp = (KP)__builtin_amdgcn_kernarg_segment_ptr();
    const int lo = kp->lo, hi = kp->hi;
    int ph = 0;
#define PH_BEGIN { if (ph >= lo && ph < hi) { KP pp = kp; asm volatile("" : "+s"(pp)); unsigned char* ws = pp->ws; \
    sq_t* sq = (sq_t*)(ws + OFF_SQ); const float* cs = (const float*)(ws + OFF_COS); const float* sn = (const float*)(ws + OFF_SIN); \
    bf16_t* xb = (bf16_t*)(ws + OFF_XB); bf16_t* zb = (bf16_t*)(ws + U_Z); (void)sq; (void)cs; (void)sn; (void)xb; (void)zb;
#define PH_END if (ph + 1 < hi) { xcd_barrier((unsigned*)(ws + OFF_BAR), bst, TID(wv)); if (REP & 16) xcd_barrier((unsigned*)(ws + OFF_BAR), bst, TID(wv)); } } ++ph; }

    if (hi < 0) grid.sync();
    volatile LAS unsigned* bst = (volatile LAS unsigned*)((LAS unsigned char*)smem + 131072);
    if (hi - lo > 1) {
        const int t0 = TID(wv);
        if (t0 < 2) bst[t0] = 0u;
        __syncthreads();
        if (t0 == 0) (void)xb_add(&((unsigned*)(kp->ws + OFF_BAR))[XB_XCNT(xb_xcc_id())], 1u);
    }

    PH_BEGIN for (int rep = 0; rep < ((REP & 8) ? 2 : 1); ++rep) prologue(wv, pp, ws, smem); PH_END

    for (int L = 0; L < 4; ++L) {
        const int j = L >> 1;
        const bool even = (L & 1) == 0;
        for (int half = 0; half < 2; ++half) {
            if (half == 0) {
                if (even) { if (EN2 & 1) {
                    PH_BEGIN {
                        EpiInEven e{zb, sq + (size_t)L * R, sq + (size_t)(9 + j) * R, sq + (size_t)(11 + j) * R, (bf16_t*)(ws + U_EV_K), cs, sn};
                        if (EN & 2) gemm_phase(wv, smem, xb, 1024, (const bf16_t*)(ws + WT_EVIN) + (size_t)j * EV_IN_PAD * 1024, 0, 1024, R / 256, EV_IN_PAD / 256, e);
                    } PH_END
                    PH_BEGIN {
                        for (int rep = 0; rep < ((REP & 4) ? 2 : 1); ++rep) {
                        EpiQ eq{(bf16_t*)(ws + U_EV_Q), sq + (size_t)(9 + j) * R, cs, sn};
                        if (EN & 4) gemm_phase(wv, smem, zb + 1536, EV_ZLD, (const bf16_t*)(ws + WT_EVQ) + (size_t)j * 768 * 384, 0, 384, R / 256, 3, eq);
                        EpiKV ek{(bf16_t*)(ws + U_EV_K), (bf16_t*)(ws + U_EV_VT), sq + (size_t)(11 + j) * R};
                        if (EN & 8) gemm_phase(wv, smem, zb + 1920, EV_ZLD, (const bf16_t*)(ws + WT_EVKV) + (size_t)j * 1024 * 256, 0, 256, R / 256, 4, ek);
                        if (EN & 16) conv_phase(wv, zb, pp->ev_conv + (size_t)j * 3 * 512, (bf16_t*)(ws + U_EV_MIX)); }
                    } PH_END
                    PH_BEGIN for (int rep = 0; rep < ((REP & 2) ? 2 : 1); ++rep) attn_phase(wv, smem, (const bf16_t*)(ws + U_EV_Q), (const bf16_t*)(ws + U_EV_K), (const bf16_t*)(ws + U_EV_VT), (bf16_t*)(ws + U_EV_MIX)); PH_END
                } } else { if (EN2 & 2) {
                    PH_BEGIN {
                        EpiInOdd e{zb, (float*)(ws + OFF_GLOW), sq + (size_t)L * R};
                        if (EN & 64) gemm_phase(wv, smem, xb, 1024, (const bf16_t*)(ws + WT_ODIN) + (size_t)j * OD_IN_PAD * 1024, 0, 1024, R / 256, OD_IN_PAD / 256, e);
                    } PH_END
                    PH_BEGIN for (int rep = ((REP & 32) ? 0 : 1); rep < 2; ++rep) gla_prep(wv, rep == 0, smem, zb, (const float*)(ws + OFF_GLOW), pp->od_wg2 + (size_t)j * 16 * 512, pp->od_bg2 + (size_t)j * 512, (bf16_t*)(ws + U_OD_KLT), (bf16_t*)(ws + U_OD_AT), (float*)(ws + U_OD_DEC)); PH_END
                    PH_BEGIN for (int rep = ((REP & 64) ? 0 : 1); rep < 2; ++rep) gla_scan(wv, rep == 0, smem, zb, (const bf16_t*)(ws + U_OD_KLT), (const bf16_t*)(ws + U_OD_AT), (const float*)(ws + U_OD_DEC), sq + (size_t)(13 + 4 * j) * R); PH_END
                    PH_BEGIN for (int rep = ((REP & 128) ? 0 : 1); rep < 2; ++rep) gla_gate(wv, zb, sq + (size_t)(13 + 4 * j) * R, pp->od_og + (size_t)j * 256, (bf16_t*)(ws + U_OD_MIX)); PH_END
                } }
            } else if (EN2 & 4) {
                PH_BEGIN {
                    EpiMlp1 e{(bf16_t*)(ws + U_HID), sq + (size_t)(((even ? (EN2 & 1) : (EN2 & 2)) ? 4 + L : L)) * R};
                    for (int rep = 0; rep < ((REP & 1) ? 2 : 1); ++rep) gemm_phase(wv, smem, xb, 1024, (const bf16_t*)(ws + WT_W1) + (size_t)L * 4096 * 1024, 1, 1024, R / 256, 16, e);
                } PH_END
            }
            if (half == 0 ? (even ? (EN2 & 1) : (EN2 & 2)) : (EN2 & 4)) PH_BEGIN {
                const bf16_t* A; const bf16_t* Bt; int K; sq_t* sqn;
                if (half == 0) {
                    A = (const bf16_t*)(ws + (even ? U_EV_MIX : U_OD_MIX));
                    Bt = (const bf16_t*)(ws + (even ? WT_EVOUT : WT_ODOUT)) + (size_t)j * 1024 * 1024; K = 1024; sqn = sq + (size_t)(4 + L) * R;
                } else {
                    A = (const bf16_t*)(ws + U_HID); Bt = (const bf16_t*)(ws + WT_W2) + (size_t)L * 1024 * 4096; K = 4096; sqn = (L < 3) ? sq + (size_t)(L + 1) * R : sq + (size_t)8 * R;
                }
                const float* xin = (!XCOPY && L == 0 && half == 0) ? pp->x : pp->out;
                EpiResid e{xin, pp->out, xb, sqn, !(L == 3 && half == 1)};
                if (EN & 2048) gemm_phase(wv, smem, A, K, Bt, 0, K, R / 256, 4, e);
            } PH_END
        }
    }
    PH_BEGIN if (EN & 4096) final_phase(wv, pp->out, sq + (size_t)8 * R, pp->fin_g); PH_END
}
constexpr int N_PHASES = 1 + 2 * 6 + 2 * 7 + 1;

extern "C" void kernel_launch(void* const* d_in, const int* in_sizes, int n_in, void* d_out, int out_size, void* d_ws, size_t ws_size, hipStream_t stream) {
    static int grid_blocks = 0;
    if (grid_blocks == 0) {
        if (n_in != 19 || ws_size < WS_NEED) { fprintf(stderr, "kernel_launch: need 19 inputs and %zu bytes of workspace, got %d and %zu\n", (size_t)WS_NEED, n_in, ws_size); grid_blocks = -1; return; }
        int dev = 0, cus = 0, per_cu = 0;
        hipGetDevice(&dev);
        hipDeviceGetAttribute(&cus, hipDeviceAttributeMultiprocessorCount, dev);
        if (hipFuncSetAttribute((const void*)mega, hipFuncAttributeMaxDynamicSharedMemorySize, LDS_BYTES) != hipSuccess) { fprintf(stderr, "kernel_launch: hipFuncSetAttribute failed\n"); grid_blocks = -1; return; }
        if (hipOccupancyMaxActiveBlocksPerMultiprocessor(&per_cu, (const void*)mega, NTHREADS, LDS_BYTES) != hipSuccess || per_cu < 1) { fprintf(stderr, "kernel_launch: occupancy query says %d\n", per_cu); per_cu = 1; (void)hipGetLastError(); }
        grid_blocks = cus * per_cu;
    }
    if (grid_blocks < 0) return;
    Params p{};
    p.x = (const float*)d_in[0]; p.pos = (const int*)d_in[1]; p.mix_g = (const float*)d_in[2]; p.mlp_g = (const float*)d_in[3]; p.fin_g = (const float*)d_in[4];
    p.ev_w_in = (const float*)d_in[5]; p.ev_conv = (const float*)d_in[6]; p.ev_qg = (const float*)d_in[7]; p.ev_wqb = (const float*)d_in[8]; p.ev_kvg = (const float*)d_in[9];
    p.ev_wkvb = (const float*)d_in[10]; p.ev_wout = (const float*)d_in[11]; p.od_w_in = (const float*)d_in[12]; p.od_wg2 = (const float*)d_in[13]; p.od_bg2 = (const float*)d_in[14];
    p.od_og = (const float*)d_in[15]; p.od_wout = (const float*)d_in[16]; p.w1 = (const float*)d_in[17]; p.w2 = (const float*)d_in[18];
    p.out = (float*)d_out; p.ws = (unsigned char*)d_ws;
#if MULTI_LAUNCH
    for (int k = 0; k < N_PHASES; ++k) {
        p.lo = k; p.hi = k + 1;
        hipLaunchKernelGGL(mega, dim3(grid_blocks), dim3(NTHREADS), LDS_BYTES, stream, p);
    }
#else
    p.lo = 0; p.hi = N_PHASES;
    if (hipMemsetAsync((unsigned char*)d_ws + OFF_BAR, 0, 16384, stream) != hipSuccess) { fprintf(stderr, "kernel_launch: memset of barrier words failed\n"); return; }
    void* args[] = {&p};
    hipError_t e = hipLaunchCooperativeKernel((const void*)mega, dim3(grid_blocks), dim3(NTHREADS), args, LDS_BYTES, stream);
    if (e != hipSuccess) fprintf(stderr, "cooperative launch failed: %s (grid %d)\n", hipGetErrorString(e), grid_blocks);
#endif
}
```

```cpp
#include <hip/hip_runtime.h>
#include <hip/hip_cooperative_groups.h>
#include <hip/amd_detail/amd_hip_unsafe_atomics.h>
#include <cstdio>
#include <cstdint>
namespace cg = cooperative_groups;

#ifndef EN
#define EN 0xffff
#endif
#ifndef REP
#define REP 0
#endif
#ifndef EN2
#define EN2 7
#define XCOPY 0
#endif
#ifndef MULTI_LAUNCH
#define MULTI_LAUNCH 0
#endif

typedef unsigned short bf16_t;
typedef short bf16x8 __attribute__((ext_vector_type(8)));
typedef short s16x4 __attribute__((ext_vector_type(4)));
typedef float f32x4 __attribute__((ext_vector_type(4)));
typedef float f32x16 __attribute__((ext_vector_type(16)));
typedef unsigned u32x4 __attribute__((ext_vector_type(4)));
typedef unsigned u32x2 __attribute__((ext_vector_type(2)));
#define DI __device__ __forceinline__

constexpr int R = 32768;
constexpr int SEQ = 4096;
constexpr int DM = 1024;
constexpr int DFF = 4096;
constexpr int EV_IN = 2208, EV_IN_PAD = 2304, EV_ZLD = 2176;
constexpr int OD_IN = 3088, OD_IN_PAD = 3328, OD_ZLD = 3072;
constexpr float EPS = 1e-6f;
constexpr float QSCALE = 0.10206207261596575f * 1.4426950408889634f;
constexpr float GLA_QSCALE = 0.08838834764831845f;
constexpr int NTHREADS = 512;
constexpr int LDS_BYTES = 131072 + 64;

constexpr size_t WT_EVIN = 0;
constexpr size_t WT_EVQ = WT_EVIN + (size_t)2 * EV_IN_PAD * 1024 * 2;
constexpr size_t WT_EVKV = WT_EVQ + (size_t)2 * 768 * 384 * 2;
constexpr size_t WT_EVOUT = WT_EVKV + (size_t)2 * 1024 * 256 * 2;
constexpr size_t WT_ODIN = WT_EVOUT + (size_t)2 * 1024 * 1024 * 2;
constexpr size_t WT_ODOUT = WT_ODIN + (size_t)2 * OD_IN_PAD * 1024 * 2;
constexpr size_t WT_W1 = WT_ODOUT + (size_t)2 * 1024 * 1024 * 2;
constexpr size_t WT_W2 = WT_W1 + (size_t)4 * 4096 * 1024 * 2;
constexpr size_t OFF_XB = WT_W2 + (size_t)4 * 4096 * 1024 * 2;
constexpr size_t OFF_SQ = OFF_XB + (size_t)R * 1024 * 2;
constexpr size_t SQ_FLOATS = (size_t)21 * R;
constexpr size_t OFF_COS = OFF_SQ + SQ_FLOATS * 8;
constexpr size_t OFF_SIN = OFF_COS + (size_t)R * 16 * 4;
constexpr size_t OFF_GLOW = OFF_SIN + (size_t)R * 16 * 4;
constexpr size_t OFF_BAR = OFF_GLOW + (size_t)R * 16 * 4;
constexpr size_t OFF_U = OFF_BAR + 16384;
constexpr size_t U_HID = OFF_U;
constexpr size_t U_Z = OFF_U;
constexpr size_t U_EV_MIX = OFF_U + (size_t)R * EV_ZLD * 2;
constexpr size_t U_EV_Q = U_EV_MIX + (size_t)R * 1024 * 2;
constexpr size_t U_EV_K = U_EV_Q + (size_t)64 * 4096 * 96 * 2;
constexpr size_t U_EV_VT = U_EV_K + (size_t)64 * 4096 * 96 * 2;
constexpr size_t U_EV_END = U_EV_VT + (size_t)64 * 64 * 4096 * 2;
constexpr size_t U_OD_MIX = OFF_U + (size_t)R * OD_ZLD * 2;
constexpr size_t U_OD_KLT = U_OD_MIX + (size_t)R * 1024 * 2;
constexpr size_t U_OD_AT = U_OD_KLT + (size_t)2048 * 128 * 64 * 2;
constexpr size_t U_OD_DEC = U_OD_AT + (size_t)2048 * 64 * 64 * 2;
constexpr size_t U_OD_END = U_OD_DEC + (size_t)2048 * 128 * 4;
constexpr size_t U_HID_END = U_HID + (size_t)R * 4096 * 2;
constexpr size_t WS_NEED = (U_EV_END > U_OD_END ? (U_EV_END > U_HID_END ? U_EV_END : U_HID_END) : (U_OD_END > U_HID_END ? U_OD_END : U_HID_END));

struct Params {
    const float* x; const int* pos; const float* mix_g; const float* mlp_g; const float* fin_g;
    const float* ev_w_in; const float* ev_conv; const float* ev_qg; const float* ev_wqb; const float* ev_kvg; const float* ev_wkvb; const float* ev_wout;
    const float* od_w_in; const float* od_wg2; const float* od_bg2; const float* od_og; const float* od_wout;
    const float* w1; const float* w2;
    float* out; unsigned char* ws; int lo, hi;
};

DI unsigned pk2(float a, float b) {
    typedef __bf16 bf2 __attribute__((ext_vector_type(2)));
    bf2 v; v.x = (__bf16)a; v.y = (__bf16)b; return __builtin_bit_cast(unsigned, v);
}
DI bf16_t f2bf(float a) { __bf16 v = (__bf16)a; return __builtin_bit_cast(bf16_t, v); }
DI float bf2f(bf16_t u) { return __uint_as_float(((unsigned)u) << 16); }
DI float bflo(unsigned u) { return __uint_as_float(u << 16); }
DI float bfhi(unsigned u) { return __uint_as_float(u & 0xffff0000u); }
DI void st_bf4(bf16_t* p, f32x4 v) { u32x2 w; w.x = pk2(v[0], v[1]); w.y = pk2(v[2], v[3]); *(u32x2*)p = w; }
DI int TID(int wv) { int lane; asm volatile("v_mbcnt_lo_u32_b32 %0, -1, 0\n\tv_mbcnt_hi_u32_b32 %0, -1, %0" : "=v"(lane)); asm volatile("" : "+s"(wv)); return wv * 64 + lane; }
DI int BID() { int b = blockIdx.x; asm volatile("" : "+s"(b)); return b; }
DI int GDIM() { int g = gridDim.x; asm volatile("" : "+s"(g)); return g; }
DI void st_bf8_sw(bf16_t* p32, f32x4 v0, f32x4 v1, int fq) {
    const unsigned a0 = pk2(v0[0], v0[1]), a1 = pk2(v0[2], v0[3]), b0 = pk2(v1[0], v1[1]), b1 = pk2(v1[2], v1[3]);
    const auto r0 = __builtin_amdgcn_permlane16_swap(a0, b0, false, false);
    const auto r1 = __builtin_amdgcn_permlane16_swap(a1, b1, false, false);
    u32x4 w; w.x = r0[0]; w.y = r1[0]; w.z = r0[1]; w.w = r1[1];
    *(u32x4*)(p32 + 8 * (fq >> 1) + 16 * (fq & 1)) = w;
}
DI void st_bf8_sw32(bf16_t* p16, f32x4 ga, f32x4 gb, int h) {
    const unsigned a0 = pk2(ga[0], ga[1]), a1 = pk2(ga[2], ga[3]), b0 = pk2(gb[0], gb[1]), b1 = pk2(gb[2], gb[3]);
    const auto r0 = __builtin_amdgcn_permlane32_swap(a0, b0, false, false);
    const auto r1 = __builtin_amdgcn_permlane32_swap(a1, b1, false, false);
    u32x4 w; w.x = r0[0]; w.y = r1[0]; w.z = r0[1]; w.w = r1[1];
    *(u32x4*)(p16 + 8 * h) = w;
}
DI int crow(int reg, int h) { return (reg & 3) + 8 * (reg >> 2) + 4 * h; }
#define MFMA32(a, b, c) __builtin_amdgcn_mfma_f32_32x32x16_bf16((a), (b), (c), 0, 0, 0)
#define MFMA16(a, b, c) __builtin_amdgcn_mfma_f32_16x16x32_bf16((a), (b), (c), 0, 0, 0)
DI bf16x8 pack8(const f32x16& x, int s) {
    u32x4 p; p.x = pk2(x[8 * s], x[8 * s + 1]); p.y = pk2(x[8 * s + 2], x[8 * s + 3]); p.z = pk2(x[8 * s + 4], x[8 * s + 5]); p.w = pk2(x[8 * s + 6], x[8 * s + 7]);
    return __builtin_bit_cast(bf16x8, p);
}

constexpr int BM = 256, BK = 64, HALF = 128, NXCD = 8, WGM = 8, HT = HALF * BK;
DI int lds_byte(int r, int c) { int st = (r >> 4) * 2 + (c >> 5), rr = r & 15, cc = c & 31, ob = rr * 64 + cc * 2; return st * 1024 + (ob ^ (((ob >> 9) & 1) << 5)); }
DI void stage_rc(int b, int& Rr, int& Cc) { int st = b / 1024, sb = b % 1024, swz = sb ^ (((sb >> 9) & 1) << 5); Rr = (st >> 1) * 16 + swz / 64; Cc = (st & 1) * 32 + (swz % 64) / 2; }

#define LAS __attribute__((address_space(3)))
template <class Epi>
DI void gemm_phase(int wv, unsigned char* smem, const bf16_t* __restrict__ A, int lda, const bf16_t* __restrict__ Bt  , int rev  , int K, int nM, int nN, const Epi& epi) {
    LAS unsigned char* lds = (LAS unsigned char*)smem;
    const int tid = TID(wv); const int bid = BID(), gdim = GDIM();
    const int wid = __builtin_amdgcn_readfirstlane(tid >> 6), lane = tid & 63, wr = wid >> 2, wc = wid & 3, fr = lane & 15, fq = lane >> 4;
    const int nwg = nM * nN, nt = K / BK, ldb = nN * BM;
    unsigned voffA[2], voffB[2];
#pragma unroll
    for (int i = 0; i < 2; ++i) { int r_, c_; stage_rc(tid * 16 + i * 8192, r_, c_); voffA[i] = (unsigned)(r_ * lda + c_) * 2u;
        const unsigned b_ = (unsigned)(tid * 16 + i * 8192), krow = b_ >> 8, chp = (b_ >> 4) & 15u, ch = chp ^ (((krow & 3u) << 2) | ((krow >> 2) & 3u));
        voffB[i] = (krow * (unsigned)ldb + ch * 8u) * 2u; }
    const size_t kstep = (size_t)(BK * 2), kstepB = (size_t)BK * ldb * 2;
    const size_t hstepA = (size_t)HALF * lda * 2, hstepB = (size_t)HALF * 2;
    const unsigned ldsw = (unsigned)wid * 1024u;
    const int aoff = lds_byte(wr * 64 + fr, fq * 8);
    unsigned trb[2][2];
    { const unsigned gq = (unsigned)fq, q = (unsigned)(fr >> 2), p = (unsigned)(fr & 3);
#pragma unroll
      for (int n = 0; n < 2; ++n)
#pragma unroll
          for (int t = 0; t < 2; ++t)
              trb[n][t] = (unsigned)(size_t)lds + 256u * (8u * gq + 4u * t + q) + 16u * (4u * ((unsigned)wc ^ q) + 2u * ((unsigned)n ^ (gq & 1u)) + ((p >> 1) ^ (unsigned)t)) + 8u * (p & 1u); }
    constexpr int HTB = HALF * BK * 2;
#define G_SA(b, h) ((4 + (b) * 2 + (h)) * HTB)
#define G_SB(b, h) (((b) * 2 + (h)) * HTB)
#define G_STAGE(bufoff, gbase, voff) do { const char* _ub = (gbase); asm volatile("" : "+s"(_ub)); _Pragma("unroll") for (int _i = 0; _i < 2; ++_i) \
        __builtin_amdgcn_global_load_lds((const unsigned*)(_ub + (voff)[_i]), (LAS unsigned*)(lds + (bufoff) + ldsw + _i * 8192), 16, 0, 0); } while (0)
#define G_LDA(dst, b, h) do { _Pragma("unroll") for (int m = 0; m < 4; ++m) _Pragma("unroll") for (int k = 0; k < 2; ++k) dst[m][k] = *(const LAS bf16x8*)(lds + G_SA(b, h) + aoff + m * 2048 + k * 1024); } while (0)
#define G_TR(dst_, addr_, imm_) asm volatile("ds_read_b64_tr_b16 %0, %1 offset:%2" : "=v"(dst_) : "v"(addr_), "n"(imm_) : "memory")
#define G_LDB(dst, b, h) do { _Pragma("unroll") for (int n = 0; n < 2; ++n) _Pragma("unroll") for (int k = 0; k < 2; ++k) _Pragma("unroll") for (int t = 0; t < 2; ++t) { \
        if (k == 0) G_TR(dst[n][k][t], trb[n][t], G_SB(b, h)); else G_TR(dst[n][k][t], trb[n][t], G_SB(b, h) + 8192); } } while (0)
#define G_FRAG(x) __builtin_bit_cast(bf16x8, __builtin_shufflevector((x)[0], (x)[1], 0, 1, 2, 3))
#define G_MMA(ai, bj, At_, Bt_) do { __builtin_amdgcn_s_setprio(1); _Pragma("unroll") for (int m = 0; m < 4; ++m) _Pragma("unroll") for (int n = 0; n < 2; ++n) _Pragma("unroll") for (int k = 0; k < 2; ++k) \
        acc[ai][bj][m][n] = MFMA16(G_FRAG(Bt_[n][k]), At_[m][k], acc[ai][bj][m][n]); __builtin_amdgcn_s_setprio(0); } while (0)
#define G_WAIT_V(n) asm volatile("s_waitcnt vmcnt(" #n ")" ::: "memory")
#define G_WAIT_L(n) asm volatile("s_waitcnt lgkmcnt(" #n ")" ::: "memory")
#define G_WAIT_LB() asm volatile("s_waitcnt lgkmcnt(0)" : "+v"(B0[0][0][0]), "+v"(B0[0][0][1]), "+v"(B0[0][1][0]), "+v"(B0[0][1][1]), "+v"(B0[1][0][0]), "+v"(B0[1][0][1]), "+v"(B0[1][1][0]), "+v"(B0[1][1][1]), \
        "+v"(B1[0][0][0]), "+v"(B1[0][0][1]), "+v"(B1[0][1][0]), "+v"(B1[0][1][1]), "+v"(B1[1][0][0]), "+v"(B1[1][0][1]), "+v"(B1[1][1][0]), "+v"(B1[1][1][1]) :: "memory")
#define G_BAR __builtin_amdgcn_s_barrier()
#define G_SCHED __builtin_amdgcn_sched_barrier(0)
#define TILE_RC(T_, BR_, BC_) do { int wgid = (T_); \
        { int q = nwg / NXCD, r = nwg % NXCD, xcd = wgid % NXCD, off = wgid / NXCD; if (rev && r == 0) off = q - 1 - off; wgid = (xcd < r ? xcd * (q + 1) : r * (q + 1) + (xcd - r) * q) + off; } \
        const int nig = WGM * nN, gid = wgid / nig, fm = gid * WGM, gsz = min(nM - fm, WGM); \
        BR_ = (fm + ((wgid % nig) % gsz)) * BM; BC_ = ((wgid % nig) / gsz) * BM; } while (0)
    int tile = bid;
    if (tile >= nwg) return;
    int brow, bcol; TILE_RC(tile, brow, bcol);
    f32x4 acc[2][2][4][2];
#pragma unroll
    for (int a = 0; a < 2; ++a)
#pragma unroll
        for (int b = 0; b < 2; ++b)
#pragma unroll
            for (int m = 0; m < 4; ++m)
#pragma unroll
                for (int n = 0; n < 2; ++n) acc[a][b][m][n] = (f32x4){0.f, 0.f, 0.f, 0.f};
    bf16x8 At[4][2]; u32x2 B0[2][2][2], B1[2][2][2];
    const char* cA = (const char*)A + (size_t)brow * lda * 2; const char* cB = (const char*)Bt + (size_t)bcol * 2;
    G_STAGE(G_SB(0, 0), cB, voffB); G_STAGE(G_SB(0, 1), cB + hstepB, voffB); G_STAGE(G_SA(0, 0), cA, voffA); G_STAGE(G_SA(0, 1), cA + hstepA, voffA);
    if (wr == 1) G_BAR;
    G_WAIT_V(2); G_BAR;
    G_STAGE(G_SB(1, 0), cB + kstepB, voffB); G_STAGE(G_SA(1, 0), cA + kstep, voffA); G_STAGE(G_SB(1, 1), cB + hstepB + kstepB, voffB);
    G_WAIT_V(6); G_BAR;
    for (;;) {
        const int ntile = tile + gdim; const bool has_next = ntile < nwg;
        int nbrow = brow, nbcol = bcol; if (has_next) TILE_RC(ntile, nbrow, nbcol);
        const char* nA = has_next ? (const char*)A + (size_t)nbrow * lda * 2 : cA; const char* nB = has_next ? (const char*)Bt + (size_t)nbcol * 2 : cB;
        for (int t = 0; t < nt; t += 2) {
            const bool last = (t == nt - 2);
            const char* a1 = cA + (size_t)(t + 1) * kstep;
            const char* a2 = last ? nA : cA + (size_t)(t + 2) * kstep; const char* b2 = last ? nB : cB + (size_t)(t + 2) * kstepB;
            const char* a3 = a2 + kstep; const char* b3 = b2 + kstepB;
            G_LDB(B0, 0, 0); G_LDB(B1, 0, 1); G_SCHED; G_LDA(At, 0, 0); G_STAGE(G_SA(1, 1), a1 + hstepA, voffA);
            G_WAIT_V(8); G_WAIT_LB(); G_BAR; G_MMA(0, 0, At, B0); G_MMA(0, 1, At, B1); G_BAR; G_SCHED;
            G_LDA(At, 0, 1); G_STAGE(G_SB(0, 0), b2, voffB); G_STAGE(G_SB(0, 1), b2 + hstepB, voffB); G_STAGE(G_SA(0, 0), a2, voffA);
            G_WAIT_V(8); G_WAIT_L(0); G_BAR; G_MMA(1, 0, At, B0); G_MMA(1, 1, At, B1); G_BAR; G_SCHED;
            G_LDB(B0, 1, 0); G_LDB(B1, 1, 1); G_SCHED; G_LDA(At, 1, 0); G_STAGE(G_SA(0, 1), a2 + hstepA, voffA);
            G_WAIT_V(8); G_WAIT_LB(); G_BAR; G_MMA(0, 0, At, B0); G_MMA(0, 1, At, B1); G_BAR; G_SCHED;
            G_LDA(At, 1, 1); G_STAGE(G_SB(1, 0), b3, voffB); G_STAGE(G_SB(1, 1), b3 + hstepB, voffB); G_STAGE(G_SA(1, 0), a3, voffA);
            G_WAIT_V(8); G_WAIT_L(0); G_BAR; G_MMA(1, 0, At, B0); G_MMA(1, 1, At, B1); G_BAR; G_SCHED;
        }
        if (wr == 0) G_BAR;
        { const int t2 = TID(wv); const int l2 = t2 & 63, w2 = t2 >> 6; epi(acc, brow, bcol, w2 >> 2, w2 & 3, l2 & 15, l2 >> 4); }
        if (!has_next) break;
#pragma unroll
        for (int a = 0; a < 2; ++a)
#pragma unroll
            for (int b = 0; b < 2; ++b)
#pragma unroll
                for (int m = 0; m < 4; ++m)
#pragma unroll
                    for (int n = 0; n < 2; ++n) acc[a][b][m][n] = (f32x4){0.f, 0.f, 0.f, 0.f};
        tile = ntile; brow = nbrow; bcol = nbcol; cA = nA; cB = nB;
        if (wr == 1) G_BAR;
    }
    G_WAIT_V(0);
    G_BAR;
}

#define EROW(ai, m) (brow + (ai) * 128 + wr * 64 + (m) * 16 + fr)
#define ECOL(bj, n) (bcol + (bj) * 128 + wc * 32 + (n) * 16 + fq * 4)
typedef unsigned long long sq_t;
DI void sq_add(sq_t* p, float v) { atomicAdd(p, (sq_t)(v * 16777216.0f)); }
DI float sq_get(const sq_t* p) { return (float)(long long)(*p) * (1.0f / 16777216.0f); }
DI sq_t sq_raw(const sq_t* p) { return *p; }
DI float sq_cvt(sq_t v) { return (float)(long long)v * (1.0f / 16777216.0f); }
DI float shx(float v, int mask, int lane) { return __int_as_float(__builtin_amdgcn_ds_bpermute((lane ^ mask) << 2, __float_as_int(v))); }
DI float shx32(float v, int lane) {
    const unsigned u = (unsigned)__float_as_int(v);
    const auto r = __builtin_amdgcn_permlane32_swap(u, u, false, false);
    return __int_as_float((int)((lane & 32) ? r[0] : r[1]));
}
DI float shx16(float v, int lane) {
    const unsigned u = (unsigned)__float_as_int(v);
    const auto r = __builtin_amdgcn_permlane16_swap(u, u, false, false);
    return __int_as_float((int)((lane & 16) ? r[0] : r[1]));
}
DI float red_fq(float v, int lane) { v += shx16(v, lane); v += shx32(v, lane); return v; }
DI float dot4(f32x4 v) { return v[0] * v[0] + v[1] * v[1] + v[2] * v[2] + v[3] * v[3]; }

struct EpiInEven {
    bf16_t* z; const sq_t* sq_in; sq_t* sq_q; sq_t* sq_kv; bf16_t* Kb; const float* cs; const float* sn;
    DI void operator()(f32x4 (&acc)[2][2][4][2], int brow, int bcol, int wr, int wc, int fr, int fq) const {
        sq_t rsq[2][4];
#pragma unroll
        for (int ai = 0; ai < 2; ++ai)
#pragma unroll
            for (int m = 0; m < 4; ++m) rsq[ai][m] = sq_raw(sq_in + EROW(ai, m));
        const bool has_norm = bcol >= 1536;
        const bool rope = (bcol == 2048 && wc == 0);
#pragma unroll
        for (int ai = 0; ai < 2; ++ai) {
            asm volatile("" ::: "memory");
            f32x4 c4v[4], s4v[4];
            if (rope) {
#pragma unroll
                for (int m = 0; m < 4; ++m) { c4v[m] = *(const f32x4*)(cs + (unsigned)EROW(ai, m) * 16 + fq * 4); s4v[m] = *(const f32x4*)(sn + (unsigned)EROW(ai, m) * 16 + fq * 4); }
            }
#pragma unroll
            for (int m = 0; m < 4; ++m) {
                const int row = EROW(ai, m);
                const float rs = rsqrtf(sq_cvt(rsq[ai][m]) * (1.0f / 1024.0f) + EPS);
                float aq = 0.f, akv = 0.f;
#pragma unroll
                for (int bj = 0; bj < 2; ++bj) {
                    const int c32 = bcol + bj * 128 + wc * 32;
                    const f32x4 v0 = acc[ai][bj][m][0] * rs, v1 = acc[ai][bj][m][1] * rs;
                    if (c32 < EV_ZLD) st_bf8_sw(z + (unsigned)row * EV_ZLD + c32, v0, v1, fq);
                    if (has_norm) { const float ss = dot4(v0) + dot4(v1); if (c32 >= 1536 && c32 < 1920) aq += ss; else if (c32 >= 1920 && c32 < 2176) akv += ss; }
                }
                if (has_norm) {
                    aq = red_fq(aq, fq * 16 + fr); akv = red_fq(akv, fq * 16 + fr);
                    if (fq == 0) { if (bcol < 2048) sq_add(sq_q + row, aq); if (bcol >= 1792) sq_add(sq_kv + row, akv); }
                }
                if (rope) {
                    const f32x4 t1 = acc[ai][1][m][0] * rs, t2 = acc[ai][1][m][1] * rs;
                    const f32x4 c4 = c4v[m], s4 = s4v[m];
                    const f32x4 o1 = t1 * c4 - t2 * s4, o2 = t2 * c4 + t1 * s4;
                    const int b = row >> 12, s = row & 4095;
#pragma unroll
                    for (int hh = 0; hh < 8; ++hh) st_bf8_sw(Kb + ((unsigned)(b * 8 + hh) * 4096 + s) * 96 + 64, o1, o2, fq);
                }
            }
        }
    }
};
struct EpiQ {
    bf16_t* Qb; const sq_t* sq; const float* cs; const float* sn;
    DI void operator()(f32x4 (&acc)[2][2][4][2], int brow, int bcol, int wr, int wc, int fr, int fq) const {
        sq_t rsq[2][4];
#pragma unroll
        for (int ai = 0; ai < 2; ++ai)
#pragma unroll
            for (int m = 0; m < 4; ++m) rsq[ai][m] = sq_raw(sq + EROW(ai, m));
        const bool rope0 = ((bcol + wc * 32) % 96) == 64, rope1 = ((bcol + 128 + wc * 32) % 96) == 64;
#pragma unroll
        for (int ai = 0; ai < 2; ++ai) {
            asm volatile("" ::: "memory");
            f32x4 c4v[4], s4v[4];
            if (rope0 || rope1) {
#pragma unroll
                for (int m = 0; m < 4; ++m) { c4v[m] = *(const f32x4*)(cs + (unsigned)EROW(ai, m) * 16 + fq * 4); s4v[m] = *(const f32x4*)(sn + (unsigned)EROW(ai, m) * 16 + fq * 4); }
            }
#pragma unroll
            for (int m = 0; m < 4; ++m) {
                const int row = EROW(ai, m);
                const float rs = rsqrtf(sq_cvt(rsq[ai][m]) * (1.0f / 384.0f) + EPS) * QSCALE;
                const int b = row >> 12, s = row & 4095;
#pragma unroll
                for (int bj = 0; bj < 2; ++bj) {
                    const int c32 = bcol + bj * 128 + wc * 32; const int hh = c32 / 96, d32 = c32 - hh * 96;
                    f32x4 v0 = acc[ai][bj][m][0] * rs, v1 = acc[ai][bj][m][1] * rs;
                    if (d32 == 64) {
                        const f32x4 c4 = c4v[m], s4 = s4v[m];
                        const f32x4 o1 = v0 * c4 - v1 * s4, o2 = v1 * c4 + v0 * s4; v0 = o1; v1 = o2;
                    }
                    st_bf8_sw(Qb + ((unsigned)(b * 8 + hh) * 4096 + s) * 96 + d32, v0, v1, fq);
                }
            }
        }
    }
};
struct EpiKV {
    bf16_t* Kb; bf16_t* Vt; const sq_t* sq;
    DI void operator()(f32x4 (&acc)[2][2][4][2], int brow, int bcol, int wr, int wc, int fr, int fq) const {
        sq_t rsq[2][4];
#pragma unroll
        for (int ai = 0; ai < 2; ++ai)
#pragma unroll
            for (int m = 0; m < 4; ++m) rsq[ai][m] = sq_raw(sq + EROW(ai, m));
#pragma unroll
        for (int ai = 0; ai < 2; ++ai)
#pragma unroll
            for (int m = 0; m < 4; ++m) {
                asm volatile("" ::: "memory");
                const int row = EROW(ai, m);
                const float rs = rsqrtf(sq_cvt(rsq[ai][m]) * (1.0f / 256.0f) + EPS);
                const int b = row >> 12, s = row & 4095;
#pragma unroll
                for (int bj = 0; bj < 2; ++bj) {
                    const int c32 = bcol + bj * 128 + wc * 32; const int hh = c32 >> 7, r32 = c32 & 127;
                    if (r32 < 64) st_bf8_sw(Kb + ((unsigned)(b * 8 + hh) * 4096 + s) * 96 + r32, acc[ai][bj][m][0] * rs, acc[ai][bj][m][1] * rs, fq);
                    else {
#pragma unroll
                        for (int n = 0; n < 2; ++n) {
                            const f32x4 v = acc[ai][bj][m][n] * rs; const int rr = r32 + n * 16 + fq * 4;
                            bf16_t* p = Vt + ((unsigned)(b * 8 + hh) * 64 + (rr - 64)) * 4096 + s; p[0] = f2bf(v[0]); p[4096] = f2bf(v[1]); p[8192] = f2bf(v[2]); p[12288] = f2bf(v[3]);
                        }
                    }
                }
            }
    }
};
struct EpiResid {
    const float* xin; float* xout; bf16_t* xb; sq_t* sq_next; bool wxb;
    DI void operator()(f32x4 (&acc)[2][2][4][2], int brow, int bcol, int wr, int wc, int fr, int fq) const {
#pragma unroll
        for (int ai = 0; ai < 2; ++ai) {
            asm volatile("" ::: "memory");
            f32x4 xv[4][2][2];
#pragma unroll
            for (int m = 0; m < 4; ++m)
#pragma unroll
                for (int bj = 0; bj < 2; ++bj)
#pragma unroll
                    for (int n = 0; n < 2; ++n) xv[m][bj][n] = *(const f32x4*)(xin + (unsigned)EROW(ai, m) * 1024 + ECOL(bj, n));
#pragma unroll
            for (int m = 0; m < 4; ++m) {
                const int row = EROW(ai, m); float ss = 0.f;
#pragma unroll
                for (int bj = 0; bj < 2; ++bj) {
                    const unsigned p0 = (unsigned)row * 1024u + (unsigned)ECOL(bj, 0);
                    const f32x4 v0 = xv[m][bj][0] + acc[ai][bj][m][0], v1 = xv[m][bj][1] + acc[ai][bj][m][1];
                    *(f32x4*)(xout + p0) = v0; *(f32x4*)(xout + p0 + 16) = v1; ss += dot4(v0); ss += dot4(v1);
                    if (wxb) st_bf8_sw(xb + (unsigned)row * 1024u + bcol + bj * 128 + wc * 32, v0, v1, fq);
                }
                ss = red_fq(ss, fq * 16 + fr);
                if (fq == 0) sq_add(sq_next + row, ss);
            }
        }
    }
};
struct EpiMlp1 {
    bf16_t* hid; const sq_t* sq;
    DI void operator()(f32x4 (&acc)[2][2][4][2], int brow, int bcol, int wr, int wc, int fr, int fq) const {
        sq_t rsq[2][4];
#pragma unroll
        for (int ai = 0; ai < 2; ++ai)
#pragma unroll
            for (int m = 0; m < 4; ++m) rsq[ai][m] = sq_raw(sq + EROW(ai, m));
#pragma unroll
        for (int ai = 0; ai < 2; ++ai)
#pragma unroll
            for (int m = 0; m < 4; ++m) {
                asm volatile("" ::: "memory");
                const int row = EROW(ai, m);
                const float rs = rsqrtf(sq_cvt(rsq[ai][m]) * (1.0f / 1024.0f) + EPS);
#pragma unroll
                for (int bj = 0; bj < 2; ++bj) {
                    f32x4 v0 = acc[ai][bj][m][0] * rs, v1 = acc[ai][bj][m][1] * rs;
#pragma unroll
                    for (int e = 0; e < 4; ++e) { const float t0 = fmaxf(v0[e], 0.f), t1 = fmaxf(v1[e], 0.f); v0[e] = t0 * t0; v1[e] = t1 * t1; }
                    st_bf8_sw(hid + (unsigned)row * DFF + bcol + bj * 128 + wc * 32, v0, v1, fq);
                }
            }
    }
};
struct EpiInOdd {
    bf16_t* z; float* glow; const sq_t* sq_in;
    DI void operator()(f32x4 (&acc)[2][2][4][2], int brow, int bcol, int wr, int wc, int fr, int fq) const {
        sq_t rsq[2][4];
#pragma unroll
        for (int ai = 0; ai < 2; ++ai)
#pragma unroll
            for (int m = 0; m < 4; ++m) rsq[ai][m] = sq_raw(sq_in + EROW(ai, m));
#pragma unroll
        for (int ai = 0; ai < 2; ++ai)
#pragma unroll
            for (int m = 0; m < 4; ++m) {
                asm volatile("" ::: "memory");
                const int row = EROW(ai, m);
                const float rs = rsqrtf(sq_cvt(rsq[ai][m]) * (1.0f / 1024.0f) + EPS);
#pragma unroll
                for (int bj = 0; bj < 2; ++bj) {
                    const int c32 = bcol + bj * 128 + wc * 32;
                    if (c32 < OD_ZLD) st_bf8_sw(z + (unsigned)row * OD_ZLD + c32, acc[ai][bj][m][0] * rs, acc[ai][bj][m][1] * rs, fq);
                    else if (c32 == OD_ZLD) *(f32x4*)(glow + (unsigned)row * 16 + fq * 4) = acc[ai][bj][m][0] * rs;
                }
            }
    }
};

DI void conv_weight(int wv, float*  , const float* __restrict__ src, bf16_t* __restrict__ dst, int K, int N, int Npad, const float* __restrict__ g) {
    const int tid = TID(wv); const int bid = BID(), gdim = GDIM();
    const int cpr = Npad / 8, total = K * cpr;
    for (int i = bid * NTHREADS + tid; i < total; i += gdim * NTHREADS) {
        const int k = i / cpr, c8 = (i - k * cpr) * 8;
        u32x4 w = (u32x4){0u, 0u, 0u, 0u};
        if (c8 < N) {
            const f32x4 a = *(const f32x4*)(src + (size_t)k * N + c8), b = *(const f32x4*)(src + (size_t)k * N + c8 + 4);
            const float gg = g ? g[k] : 1.0f;
            w.x = pk2(a[0] * gg, a[1] * gg); w.y = pk2(a[2] * gg, a[3] * gg); w.z = pk2(b[0] * gg, b[1] * gg); w.w = pk2(b[2] * gg, b[3] * gg);
        }
        *(u32x4*)(dst + (size_t)k * Npad + c8) = w;
    }
}

typedef const __attribute__((address_space(4))) Params* KP;
DI void prologue(int wv, KP pp, unsigned char* ws, unsigned char* smem) {
    float* tile = (float*)smem;
    const int tid = TID(wv), wid = tid >> 6, lane = tid & 63; const int bid = BID(), gdim = GDIM();
    sq_t* sq = (sq_t*)(ws + OFF_SQ);
    for (size_t i = (size_t)bid * NTHREADS + tid; i < SQ_FLOATS - R; i += (size_t)gdim * NTHREADS) sq[R + i] = 0ull;
    bf16_t* xb = (bf16_t*)(ws + OFF_XB);
    for (int row = bid * 8 + wid; row < R; row += gdim * 8) {
        float ss = 0.f;
#pragma unroll
        for (int i = 0; i < 4; ++i) {
            const size_t o = (size_t)row * 1024 + i * 256 + lane * 4;
            const f32x4 v = *(const f32x4*)(pp->x + o); ss += dot4(v); st_bf4(xb + o, v);
            if (XCOPY) *(f32x4*)(pp->out + o) = v;
        }
#pragma unroll
        for (int d = 1; d < 64; d <<= 1) ss += shx(ss, d, lane);
        if (lane == 0) sq[row] = (sq_t)(ss * 16777216.0f);
    }
    float* cs = (float*)(ws + OFF_COS); float* sn = (float*)(ws + OFF_SIN);
    for (int i = bid * NTHREADS + tid; i < R * 16; i += gdim * NTHREADS) {
        const int row = i >> 4, f = i & 15;
        const float inv_freq = 1.0f / powf(10000.0f, (float)(2 * f) / 32.0f);
        const float ang = (float)pp->pos[row] * inv_freq;
        const double a = (double)ang;
        const double kq = rint(a * 0.63661977236758134308);
        const double rr = a - kq * 1.57079632679489661923;
        const double r2 = rr * rr;
        const double sp = rr * (1.0 + r2 * (-1.0 / 6 + r2 * (1.0 / 120 + r2 * (-1.0 / 5040 + r2 * (1.0 / 362880 + r2 * (-1.0 / 39916800 + r2 * (1.0 / 6227020800.0)))))));
        const double cp = 1.0 + r2 * (-0.5 + r2 * (1.0 / 24 + r2 * (-1.0 / 720 + r2 * (1.0 / 40320 + r2 * (-1.0 / 3628800 + r2 * (1.0 / 479001600.0 + r2 * (-1.0 / 87178291200.0)))))));
        const int q = ((int)kq) & 3;
        const double sv = (q == 0) ? sp : (q == 1) ? cp : (q == 2) ? -sp : -cp;
        const double cv = (q == 0) ? cp : (q == 1) ? -sp : (q == 2) ? -cp : sp;
        cs[i] = (float)cv; sn[i] = (float)sv;
    }
    for (int j = 0; j < 2; ++j) {
        conv_weight(wv, tile, pp->ev_w_in + (size_t)j * 1024 * EV_IN, (bf16_t*)(ws + WT_EVIN) + (size_t)j * EV_IN_PAD * 1024, 1024, EV_IN, EV_IN_PAD, pp->mix_g + (2 * j) * 1024);
        conv_weight(wv, tile, pp->ev_wqb + (size_t)j * 384 * 768, (bf16_t*)(ws + WT_EVQ) + (size_t)j * 768 * 384, 384, 768, 768, pp->ev_qg + j * 384);
        conv_weight(wv, tile, pp->ev_wkvb + (size_t)j * 256 * 1024, (bf16_t*)(ws + WT_EVKV) + (size_t)j * 1024 * 256, 256, 1024, 1024, pp->ev_kvg + j * 256);
        conv_weight(wv, tile, pp->ev_wout + (size_t)j * 1024 * 1024, (bf16_t*)(ws + WT_EVOUT) + (size_t)j * 1024 * 1024, 1024, 1024, 1024, nullptr);
        conv_weight(wv, tile, pp->od_w_in + (size_t)j * 1024 * OD_IN, (bf16_t*)(ws + WT_ODIN) + (size_t)j * OD_IN_PAD * 1024, 1024, OD_IN, OD_IN_PAD, pp->mix_g + (2 * j + 1) * 1024);
        conv_weight(wv, tile, pp->od_wout + (size_t)j * 1024 * 1024, (bf16_t*)(ws + WT_ODOUT) + (size_t)j * 1024 * 1024, 1024, 1024, 1024, nullptr);
    }
    for (int L = 0; L < 4; ++L) {
        conv_weight(wv, tile, pp->w1 + (size_t)L * 1024 * 4096, (bf16_t*)(ws + WT_W1) + (size_t)L * 4096 * 1024, 1024, 4096, 4096, pp->mlp_g + L * 1024);
        conv_weight(wv, tile, pp->w2 + (size_t)L * 4096 * 1024, (bf16_t*)(ws + WT_W2) + (size_t)L * 1024 * 4096, 4096, 1024, 1024, nullptr);
    }
}

DI void conv_phase(int wv, const bf16_t* __restrict__ z, const float* __restrict__ cw  , bf16_t* __restrict__ mix) {
    const int tid0 = TID(wv); const int bid = BID(), gdim = GDIM();
    for (int i = bid * NTHREADS + tid0; i < R * 64; i += gdim * NTHREADS) {
        const int row = i >> 6, c8 = (i & 63) * 8, s = row & 4095;
        const bf16_t* zr = z + (size_t)row * EV_ZLD;
        const u32x4 ab = *(const u32x4*)(zr + c8);
        float u[3][8];
#pragma unroll
        for (int k = 0; k < 3; ++k) {
            const int back = 2 - k;
            if (s >= back) {
                const u32x4 ac = *(const u32x4*)(zr - (size_t)back * EV_ZLD + 512 + c8), av = *(const u32x4*)(zr - (size_t)back * EV_ZLD + 1024 + c8);
#pragma unroll
                for (int e = 0; e < 4; ++e) { u[k][2 * e] = bflo(ac[e]) * bflo(av[e]); u[k][2 * e + 1] = bfhi(ac[e]) * bfhi(av[e]); }
            } else {
#pragma unroll
                for (int e = 0; e < 8; ++e) u[k][e] = 0.f;
            }
        }
        float y[8];
#pragma unroll
        for (int e = 0; e < 8; ++e) {
            const float conv = cw[c8 + e] * u[0][e] + cw[512 + c8 + e] * u[1][e] + cw[1024 + c8 + e] * u[2][e];
            const float abv = (e & 1) ? bfhi(ab[e >> 1]) : bflo(ab[e >> 1]);
            y[e] = abv * conv;
        }
        u32x4 w; w.x = pk2(y[0], y[1]); w.y = pk2(y[2], y[3]); w.z = pk2(y[4], y[5]); w.w = pk2(y[6], y[7]);
        *(u32x4*)(mix + (size_t)row * 1024 + c8) = w;
    }
}

DI void attn_phase(int wv, unsigned char* smem, const bf16_t* __restrict__ Qb, const bf16_t* __restrict__ Kb, const bf16_t* __restrict__ Vt, bf16_t* __restrict__ mix) {
    constexpr int KROW = 208, VROW = 136, KBUF = 64 * KROW, VBUF = 64 * VROW, BUF = KBUF + VBUF;
    const int tid = TID(wv), wid = tid >> 6, lane = tid & 63, r = lane & 31, h = lane >> 5; const int bid = BID(), gdim = GDIM();
    for (int item = bid; item < 512; item += gdim) {
        const int pp = (item >> 3) & 7, bh = (item & 7) + 8 * ((item >> 6) & 3) + 32 * (item >> 8);
        const unsigned char* Kg = (const unsigned char*)(Kb + (size_t)bh * 4096 * 96);
        const unsigned char* Vg = (const unsigned char*)(Vt + (size_t)bh * 64 * 4096);
        for (int half = 0; half < 2; ++half) {
            const int qb = half ? 15 - pp : pp;
            const int q0 = qb * 256 + wid * 32;
            const bf16_t* Qp = Qb + ((size_t)bh * 4096 + q0 + r) * 96;
            bf16x8 qf[6];
#pragma unroll
            for (int ks = 0; ks < 6; ++ks) qf[ks] = *(const bf16x8*)(Qp + 16 * ks + 8 * h);
            asm volatile("s_waitcnt vmcnt(0)" : "+v"(qf[0]), "+v"(qf[1]), "+v"(qf[2]), "+v"(qf[3]), "+v"(qf[4]), "+v"(qf[5]) :: "memory");
            f32x16 o0, o1;
#pragma unroll
            for (int i = 0; i < 16; ++i) { o0[i] = 0.f; o1[i] = 0.f; }
            float mrun = -INFINITY, lrun = 0.f;
            const int nt = 4 * (qb + 1);
            __syncthreads();
            {
                const u32x4 k0v = *(const u32x4*)(Kg + tid * 16);
                u32x4 k1v; if (tid < 256) k1v = *(const u32x4*)(Kg + (tid + 512) * 16);
                const u32x4 vv = *(const u32x4*)(Vg + (size_t)(tid >> 3) * 8192 + (tid & 7) * 16);
                *(u32x4*)(smem + (tid / 12) * KROW + (tid % 12) * 16) = k0v;
                if (tid < 256) *(u32x4*)(smem + ((tid + 512) / 12) * KROW + ((tid + 512) % 12) * 16) = k1v;
                unsigned char* vd = smem + KBUF + (tid >> 3) * VROW + (tid & 7) * 16;
                *(u32x2*)vd = (u32x2){vv.x, vv.y}; *(u32x2*)(vd + 8) = (u32x2){vv.z, vv.w};
            }
            __syncthreads();
            for (int kt = 0; kt < nt; ++kt) {
                const bool more = kt + 1 < nt;
                u32x4 k0v, k1v, vv;
                if (more) {
                    const unsigned char* kg = Kg + (size_t)(kt + 1) * 12288;
                    k0v = *(const u32x4*)(kg + tid * 16);
                    if (tid < 256) k1v = *(const u32x4*)(kg + (tid + 512) * 16);
                    vv = *(const u32x4*)(Vg + (size_t)(tid >> 3) * 8192 + (kt + 1) * 128 + (tid & 7) * 16);
                }
                const unsigned char* kb_ = smem + (kt & 1) * BUF; const unsigned char* vb_ = kb_ + KBUF;
                const int key0 = kt * 64;
                if (key0 <= q0 + 31) {
                    f32x16 s0, s1;
#pragma unroll
                    for (int i = 0; i < 16; ++i) { s0[i] = 0.f; s1[i] = 0.f; }
                    bf16x8 ka0[6], ka1[6];
#pragma unroll
                    for (int ks = 0; ks < 6; ++ks) { ka0[ks] = *(const bf16x8*)(kb_ + r * KROW + ks * 32 + h * 16); ka1[ks] = *(const bf16x8*)(kb_ + (32 + r) * KROW + ks * 32 + h * 16); }
                    __builtin_amdgcn_sched_barrier(0);
#pragma unroll
                    for (int ks = 0; ks < 6; ++ks) { s0 = MFMA32(ka0[ks], qf[ks], s0); s1 = MFMA32(ka1[ks], qf[ks], s1); }
                    if (key0 + 63 > q0) {
                        const int qpos = q0 + r;
#pragma unroll
                        for (int i = 0; i < 16; ++i) { const int key = key0 + crow(i, h); if (key > qpos) s0[i] = -INFINITY; if (key + 32 > qpos) s1[i] = -INFINITY; }
                    }
                    float mx = s0[0];
#pragma unroll
                    for (int i = 1; i < 16; ++i) mx = fmaxf(mx, s0[i]);
#pragma unroll
                    for (int i = 0; i < 16; ++i) mx = fmaxf(mx, s1[i]);
                    mx = fmaxf(mx, shx32(mx, lane));
                    const float mnew = fmaxf(mrun, mx);
                    const float alpha = __builtin_amdgcn_exp2f(mrun - mnew);
                    float ls = 0.f;
#pragma unroll
                    for (int i = 0; i < 16; ++i) { s0[i] = __builtin_amdgcn_exp2f(s0[i] - mnew); s1[i] = __builtin_amdgcn_exp2f(s1[i] - mnew); ls += s0[i] + s1[i]; }
                    lrun = lrun * alpha + ls; mrun = mnew;
#pragma unroll
                    for (int i = 0; i < 16; ++i) { o0[i] *= alpha; o1[i] *= alpha; }
                    bf16x8 pf[4];
                    pf[0] = pack8(s0, 0); pf[1] = pack8(s0, 1); pf[2] = pack8(s1, 0); pf[3] = pack8(s1, 1);
                    bf16x8 va0[4], va1[4];
#pragma unroll
                    for (int kk = 0; kk < 4; ++kk) {
                        const int koff = (kk >> 1) * 32 + (kk & 1) * 16 + 4 * h;
                        const s16x4 lo0 = *(const s16x4*)(vb_ + r * VROW + koff * 2), hi0 = *(const s16x4*)(vb_ + r * VROW + (koff + 8) * 2);
                        const s16x4 lo1 = *(const s16x4*)(vb_ + (32 + r) * VROW + koff * 2), hi1 = *(const s16x4*)(vb_ + (32 + r) * VROW + (koff + 8) * 2);
                        va0[kk] = __builtin_shufflevector(lo0, hi0, 0, 1, 2, 3, 4, 5, 6, 7);
                        va1[kk] = __builtin_shufflevector(lo1, hi1, 0, 1, 2, 3, 4, 5, 6, 7);
                    }
                    __builtin_amdgcn_sched_barrier(0);
#pragma unroll
                    for (int kk = 0; kk < 4; ++kk) { o0 = MFMA32(va0[kk], pf[kk], o0); o1 = MFMA32(va1[kk], pf[kk], o1); }
                }
                if (more) {
                    unsigned char* nb = smem + ((kt + 1) & 1) * BUF;
                    *(u32x4*)(nb + (tid / 12) * KROW + (tid % 12) * 16) = k0v;
                    if (tid < 256) *(u32x4*)(nb + ((tid + 512) / 12) * KROW + ((tid + 512) % 12) * 16) = k1v;
                    unsigned char* vd = nb + KBUF + (tid >> 3) * VROW + (tid & 7) * 16;
                    *(u32x2*)vd = (u32x2){vv.x, vv.y}; *(u32x2*)(vd + 8) = (u32x2){vv.z, vv.w};
                }
                __syncthreads();
            }
            lrun += shx32(lrun, lane);
            const float inv = 1.0f / lrun;
            const int b = bh >> 3, head = bh & 7;
            bf16_t* op = mix + ((size_t)b * 4096 + q0 + r) * 1024 + 512 + head * 64;
#pragma unroll
            for (int g = 0; g < 4; g += 2) {
                st_bf8_sw32(op + 8 * g, (f32x4){o0[4 * g] * inv, o0[4 * g + 1] * inv, o0[4 * g + 2] * inv, o0[4 * g + 3] * inv},
                            (f32x4){o0[4 * g + 4] * inv, o0[4 * g + 5] * inv, o0[4 * g + 6] * inv, o0[4 * g + 7] * inv}, h);
                st_bf8_sw32(op + 32 + 8 * g, (f32x4){o1[4 * g] * inv, o1[4 * g + 1] * inv, o1[4 * g + 2] * inv, o1[4 * g + 3] * inv},
                            (f32x4){o1[4 * g + 4] * inv, o1[4 * g + 5] * inv, o1[4 * g + 6] * inv, o1[4 * g + 7] * inv}, h);
            }
        }
    }
}

DI void gla_prep(int wv, bool dry, unsigned char* smem, bf16_t* __restrict__ z, const float* __restrict__ glow, const float* __restrict__ wg2, const float* __restrict__ bg2,
                 bf16_t* __restrict__ KLT, bf16_t* __restrict__ AT, float* __restrict__ DEC) {
    float* s_glow = (float*)smem;
    float* s_seg = (float*)(smem + 4096);
    unsigned char* s_qe = smem + 8192;
    unsigned char* s_ke = s_qe + 64 * 272;
    const int tid = TID(wv), wid = tid >> 6, lane = tid & 63, r = lane & 31, h = lane >> 5; const int bid = BID(), gdim = GDIM();
    const int dk = tid & 127, tq = tid >> 7;
    f32x4 gpre = (f32x4){0.f, 0.f, 0.f, 0.f};
    if (bid < 2048 && tid < 256) gpre = ((const f32x4*)(glow + ((size_t)(bid >> 8) * 4096 + (bid & 63) * 64) * 16))[tid];
    for (int item = bid; item < 2048; item += gdim) {
        const int n = item & 63, hh = (item >> 6) & 3, b = item >> 8;
        const size_t row0 = (size_t)b * 4096 + n * 64;
        bf16_t qraw[16], kraw[16];
#pragma unroll
        for (int tt = 0; tt < 16; ++tt) { const bf16_t* zr = z + (row0 + tq * 16 + tt) * OD_ZLD + hh * 128 + dk; qraw[tt] = zr[0]; kraw[tt] = zr[512]; }
        __syncthreads();
        if (tid < 256) {
            ((f32x4*)s_glow)[tid] = gpre;
            const int nitem = item + gdim;
            if (nitem < 2048) gpre = ((const f32x4*)(glow + ((size_t)(nitem >> 8) * 4096 + (nitem & 63) * 64) * 16))[tid];
        }
        float w[16];
#pragma unroll
        for (int j = 0; j < 16; ++j) w[j] = wg2[j * 512 + hh * 128 + dk];
        const float bb = bg2[hh * 128 + dk];
        __syncthreads();
        float la[16]; float run = 0.f;
#pragma unroll
        for (int tt = 0; tt < 16; ++tt) {
            const int t = tq * 16 + tt; float xg = bb;
#pragma unroll
            for (int j = 0; j < 16; ++j) xg += s_glow[t * 16 + j] * w[j];
            const float ls = fminf(xg, 0.f) - 0.6931471805599453f * __builtin_amdgcn_logf(1.0f + __expf(-fabsf(xg)));
            run += ls * (1.0f / 16.0f); la[tt] = run;
        }
        s_seg[tq * 128 + dk] = run;
        __syncthreads();
        float pre = 0.f, tot = 0.f;
#pragma unroll
        for (int s = 0; s < 4; ++s) { const float v = s_seg[s * 128 + dk]; if (s < tq) pre += v; tot += v; }
        unsigned klp[8];
        const float etot = __expf(tot);
#pragma unroll
        for (int tt = 0; tt < 16; tt += 2) {
            float klv[2];
#pragma unroll
            for (int e = 0; e < 2; ++e) {
                const int t = tq * 16 + tt + e; const float bc = pre + la[tt + e];
                bf16_t* zr = z + (row0 + t) * OD_ZLD + hh * 128 + dk;
                const float q = bf2f(qraw[tt + e]), k = bf2f(kraw[tt + e]);
                const float e1 = __expf(bc), e2 = __builtin_amdgcn_rcpf(e1);
                const bf16_t qe = f2bf(q * GLA_QSCALE * e1), ke = f2bf(k * e2);
                klv[e] = k * (etot * e2);
                if (!dry) zr[0] = qe;
                *(bf16_t*)(s_qe + t * 272 + dk * 2) = qe; *(bf16_t*)(s_ke + t * 272 + dk * 2) = ke;
            }
            klp[tt >> 1] = pk2(klv[0], klv[1]);
        }
        {
            u32x4* kd = (u32x4*)(KLT + ((size_t)item * 128 + dk) * 64 + tq * 16);
            if (!dry) { kd[0] = (u32x4){klp[0], klp[1], klp[2], klp[3]}; kd[1] = (u32x4){klp[4], klp[5], klp[6], klp[7]}; }
        }
        if (tq == 0 && !dry) DEC[(size_t)item * 128 + dk] = etot;
        __syncthreads();
        if (wid < 3) {
            const int jb = (wid == 2), ib = (wid >= 1);
            f32x16 acc;
#pragma unroll
            for (int i = 0; i < 16; ++i) acc[i] = 0.f;
            bf16x8 pa[8], pb[8];
#pragma unroll
            for (int ks = 0; ks < 8; ++ks) { pa[ks] = *(const bf16x8*)(s_ke + (jb * 32 + r) * 272 + ks * 32 + h * 16); pb[ks] = *(const bf16x8*)(s_qe + (ib * 32 + r) * 272 + ks * 32 + h * 16); }
            __builtin_amdgcn_sched_barrier(0);
#pragma unroll
            for (int ks = 0; ks < 8; ++ks) acc = MFMA32(pa[ks], pb[ks], acc);
            const int i_tok = ib * 32 + r;
#pragma unroll
            for (int g = 0; g < 4; g += 2) {
                f32x4 v, v2;
#pragma unroll
                for (int e = 0; e < 4; ++e) { const int j = jb * 32 + 8 * g + 4 * h + e; v[e] = (j <= i_tok) ? acc[4 * g + e] : 0.f; v2[e] = (j + 8 <= i_tok) ? acc[4 * g + 4 + e] : 0.f; }
                if (!dry) st_bf8_sw32(AT + ((size_t)item * 64 + i_tok) * 64 + jb * 32 + 8 * g, v, v2, h);
            }
        } else if (wid == 3) {
#pragma unroll
            for (int g = 0; g < 4; ++g) if (!dry) *(u32x2*)(AT + ((size_t)item * 64 + r) * 64 + 32 + 8 * g + 4 * h) = (u32x2){0u, 0u};
        }
    }
}

DI void gla_scan(int wv, bool dry, unsigned char* smem, bf16_t* __restrict__ z, const bf16_t* __restrict__ KLT, const bf16_t* __restrict__ AT, const float* __restrict__ DEC, sq_t* __restrict__ sq_o) {
    constexpr int QE_OFF = 0, KL_OFF = 17408, AT_OFF = KL_OFF + 18432, VT_OFF = AT_OFF + 9216, DEC_OFF = VT_OFF + 4608, BUF = DEC_OFF + 512;
    constexpr int ST_OFF = 2 * BUF, ST_SZ = 32 * 272;
    const int tid = TID(wv), wid = tid >> 6, lane = tid & 63, r = lane & 31, h = lane >> 5; const int bid = BID(), gdim = GDIM();
    for (int item = bid; item < 256; item += gdim) {
        const int dvs = (item >> 3) & 7, gbh = (item & 7) + 8 * (item >> 6), hh = gbh & 3, b = gbh >> 2;
        const size_t ci0 = (size_t)(b * 4 + hh) * 64;
        f32x16 S;
#pragma unroll
        for (int i = 0; i < 16; ++i) S[i] = 0.f;
        __syncthreads();
        for (int i = tid; i < ST_SZ / 4; i += NTHREADS) ((unsigned*)(smem + ST_OFF))[i] = 0u;
#define GLA_DECL(P) u32x4 P##q0, P##q1, P##k0, P##k1, P##a; u32x2 P##v; float P##d = 0.f;
#define GLA_LOAD(P, n_) do { const size_t ci = ci0 + (n_); const size_t row0 = (size_t)b * 4096 + (size_t)(n_) * 64; \
            P##q0 = *(const u32x4*)(z + (row0 + (tid >> 4)) * OD_ZLD + hh * 128 + (tid & 15) * 8); \
            P##q1 = *(const u32x4*)(z + (row0 + 32 + (tid >> 4)) * OD_ZLD + hh * 128 + (tid & 15) * 8); \
            P##k0 = *(const u32x4*)(KLT + ci * 8192 + (size_t)tid * 8); P##k1 = *(const u32x4*)(KLT + ci * 8192 + (size_t)(tid + 512) * 8); \
            P##a = *(const u32x4*)(AT + ci * 4096 + (size_t)tid * 8); \
            P##v = *(const u32x2*)(z + (row0 + (tid >> 3)) * OD_ZLD + 1024 + hh * 256 + dvs * 32 + (tid & 7) * 4); \
            if (tid < 128) P##d = DEC[ci * 128 + tid]; } while (0)
#define GLA_STORE(P, bufp) do { unsigned char* bp_ = (bufp); \
            *(u32x4*)(bp_ + QE_OFF + (tid >> 4) * 272 + (tid & 15) * 16) = P##q0; *(u32x4*)(bp_ + QE_OFF + (32 + (tid >> 4)) * 272 + (tid & 15) * 16) = P##q1; \
            *(u32x4*)(bp_ + KL_OFF + (tid >> 3) * 144 + (tid & 7) * 16) = P##k0; *(u32x4*)(bp_ + KL_OFF + (64 + (tid >> 3)) * 144 + (tid & 7) * 16) = P##k1; \
            *(u32x4*)(bp_ + AT_OFF + (tid >> 3) * 144 + (tid & 7) * 16) = P##a; \
            { const int t_ = tid >> 3, d_ = (tid & 7) * 4; bf16_t* vt_ = (bf16_t*)(bp_ + VT_OFF) + t_; \
              vt_[(d_ + 0) * 72] = (bf16_t)(P##v.x & 0xffffu); vt_[(d_ + 1) * 72] = (bf16_t)(P##v.x >> 16); vt_[(d_ + 2) * 72] = (bf16_t)(P##v.y & 0xffffu); vt_[(d_ + 3) * 72] = (bf16_t)(P##v.y >> 16); } \
            if (tid < 128) ((float*)(bp_ + DEC_OFF))[tid] = P##d; } while (0)
#define GLA_COMPUTE(n_) do { \
            const unsigned char* bp = smem + ((n_) & 1) * BUF; \
            const unsigned char* stc = smem + ST_OFF + ((n_) & 1) * ST_SZ; \
            unsigned char* stn = smem + ST_OFF + (((n_) + 1) & 1) * ST_SZ; \
            if (wid < 4) { \
                const int dkb = wid; \
                const float* dec = (const float*)(bp + DEC_OFF) + dkb * 32; \
                _Pragma("unroll") for (int i = 0; i < 16; ++i) S[i] *= dec[crow(i, h)]; \
                bf16x8 sa[4], sb[4]; \
                _Pragma("unroll") for (int ks = 0; ks < 4; ++ks) { \
                    sa[ks] = *(const bf16x8*)(bp + KL_OFF + (dkb * 32 + r) * 144 + ks * 32 + h * 16); \
                    sb[ks] = *(const bf16x8*)(bp + VT_OFF + r * 144 + ks * 32 + h * 16); } \
                __builtin_amdgcn_sched_barrier(0); \
                _Pragma("unroll") for (int ks = 0; ks < 4; ++ks) S = MFMA32(sa[ks], sb[ks], S); \
                _Pragma("unroll") for (int g = 0; g < 4; ++g) { \
                    u32x2 wv_; wv_.x = pk2(S[4 * g], S[4 * g + 1]); wv_.y = pk2(S[4 * g + 2], S[4 * g + 3]); \
                    *(u32x2*)(stn + r * 272 + (dkb * 32 + 8 * g + 4 * h) * 2) = wv_; } \
            } else if (wid < 6) { \
                const int ib = wid - 4; \
                f32x16 acc; \
                _Pragma("unroll") for (int i = 0; i < 16; ++i) acc[i] = 0.f; \
                bf16x8 oa[12], ob[12];        \
                _Pragma("unroll") for (int ks = 0; ks < 4; ++ks) { \
                    oa[ks] = *(const bf16x8*)(bp + VT_OFF + r * 144 + ks * 32 + h * 16); \
                    ob[ks] = *(const bf16x8*)(bp + AT_OFF + (ib * 32 + r) * 144 + ks * 32 + h * 16); } \
                _Pragma("unroll") for (int ks = 0; ks < 8; ++ks) { \
                    oa[4 + ks] = *(const bf16x8*)(stc + r * 272 + ks * 32 + h * 16); \
                    ob[4 + ks] = *(const bf16x8*)(bp + QE_OFF + (ib * 32 + r) * 272 + ks * 32 + h * 16); } \
                __builtin_amdgcn_sched_barrier(0); \
                _Pragma("unroll") for (int ks = 0; ks < 12; ++ks) acc = MFMA32(oa[ks], ob[ks], acc); \
                const size_t row = (size_t)b * 4096 + (size_t)(n_) * 64 + ib * 32 + r; \
                bf16_t* op = z + row * OD_ZLD + 1024 + hh * 256 + dvs * 32; \
                float ss = 0.f; \
                _Pragma("unroll") for (int g = 0; g < 4; g += 2) { \
                    const f32x4 v = (f32x4){acc[4 * g], acc[4 * g + 1], acc[4 * g + 2], acc[4 * g + 3]}; \
                    const f32x4 v2 = (f32x4){acc[4 * g + 4], acc[4 * g + 5], acc[4 * g + 6], acc[4 * g + 7]}; \
                    ss += dot4(v); ss += dot4(v2); if (!dry) st_bf8_sw32(op + 8 * g, v, v2, h); } \
                ss += shx32(ss, lane); \
                if (h == 0 && !dry) sq_add(sq_o + row * 4 + hh, ss); \
            } } while (0)
        GLA_DECL(ra) GLA_DECL(rb)
        GLA_LOAD(ra, 0);
        GLA_STORE(ra, smem);
        GLA_LOAD(ra, 1); GLA_LOAD(rb, 2);
        __syncthreads();
#pragma unroll 1
        for (int n = 0; n < 64; n += 2) {
            GLA_COMPUTE(n);
            GLA_STORE(ra, smem + ((n + 1) & 1) * BUF);
            if (n + 3 < 64) GLA_LOAD(ra, n + 3);
            __syncthreads();
            GLA_COMPUTE(n + 1);
            if (n + 2 < 64) GLA_STORE(rb, smem + (n & 1) * BUF);
            if (n + 4 < 64) GLA_LOAD(rb, n + 4);
            __syncthreads();
        }
    }
#undef GLA_DECL
#undef GLA_LOAD
#undef GLA_STORE
#undef GLA_COMPUTE
}

DI void gla_gate(int wv, const bf16_t* __restrict__ z, const sq_t* __restrict__ sq_o, const float* __restrict__ og, bf16_t* __restrict__ mix) {
    const int tid0 = TID(wv); const int bid = BID(), gdim = GDIM();
    for (int i = bid * NTHREADS + tid0; i < R * 128; i += gdim * NTHREADS) {
        const int row = i >> 7, c8 = (i & 127) * 8, hh = c8 >> 8;
        const float rs = rsqrtf(sq_get(sq_o + (size_t)row * 4 + hh) * (1.0f / 256.0f) + EPS);
        const u32x4 o8 = *(const u32x4*)(z + (size_t)row * OD_ZLD + 1024 + c8), g8 = *(const u32x4*)(z + (size_t)row * OD_ZLD + 2048 + c8);
        float y[8];
#pragma unroll
        for (int e = 0; e < 8; ++e) {
            const float o = (e & 1) ? bfhi(o8[e >> 1]) : bflo(o8[e >> 1]);
            const float g = (e & 1) ? bfhi(g8[e >> 1]) : bflo(g8[e >> 1]);
            y[e] = o * rs * og[(c8 & 255) + e] * (g / (1.0f + __expf(-g)));
        }
        u32x4 w; w.x = pk2(y[0], y[1]); w.y = pk2(y[2], y[3]); w.z = pk2(y[4], y[5]); w.w = pk2(y[6], y[7]);
        *(u32x4*)(mix + (size_t)row * 1024 + c8) = w;
    }
}

DI void final_phase(int wv, float* out, const sq_t* __restrict__ sq, const float* __restrict__ g) {
    const int tid0 = TID(wv); const int bid = BID(), gdim = GDIM();
    const int stride = gdim * NTHREADS, total = R * 256;
    for (int i0 = bid * NTHREADS + tid0; i0 < total; i0 += 8 * stride) {
        f32x4 v[8]; sq_t sv[8]; int row[8], c4[8]; bool in[8];
#pragma unroll
        for (int u = 0; u < 8; ++u) {
            const int i = i0 + u * stride; in[u] = i < total; const int ii = in[u] ? i : 0;
            row[u] = ii >> 8; c4[u] = (ii & 255) * 4;
            sv[u] = sq_raw(sq + row[u]);
            v[u] = *(const f32x4*)(out + (size_t)row[u] * 1024 + c4[u]);
        }
#pragma unroll
        for (int u = 0; u < 8; ++u) {
            if (!in[u]) continue;
            const float rs = rsqrtf(sq_cvt(sv[u]) * (1.0f / 1024.0f) + EPS);
            const f32x4 gg = *(const f32x4*)(g + c4[u]);
            *(f32x4*)(out + (size_t)row[u] * 1024 + c4[u]) = v[u] * rs * gg;
        }
    }
}

#define XB_TMO      128
#define XB_XCNT(j)  (256  + 64 * (j))
#define XB_XSUB(j)  (1280 + 64 * (j))
#define XB_XGEN(j)  (2304 + 64 * (j))
#define XB_TOP      3328
#define XB_TOPGEN   3392
#define XCD_BAR_WORDS 3456
#define XB_SPIN_CAP (1u << 18)
DI unsigned xb_ld(unsigned* p) { return __hip_atomic_load(p, __ATOMIC_RELAXED, __HIP_MEMORY_SCOPE_AGENT); }
DI unsigned xb_add(unsigned* p, unsigned v) { return __hip_atomic_fetch_add(p, v, __ATOMIC_RELAXED, __HIP_MEMORY_SCOPE_AGENT); }
DI unsigned xb_xcc_id() { return (unsigned)__builtin_amdgcn_s_getreg((3 << 11) | 20) & 0xFu; }
#define XB_SPIN(cond, bar) do { unsigned _sp = 0; while (cond) { __builtin_amdgcn_s_sleep(1); \
    if ((++_sp & 255u) == 0u) { if (xb_ld(&(bar)[XB_TMO])) break; if (_sp > XB_SPIN_CAP) { atomicAdd(&(bar)[XB_TMO], 1u); break; } } } } while (0)
DI void xcd_barrier_complete(unsigned* bar, unsigned x, unsigned& nloc, unsigned& nx) {
    const unsigned G = gridDim.x;
    unsigned sum, cnt, mine, sp = 0u;
    for (;;) {
        sum = 0u; cnt = 0u; mine = 0u;
#pragma unroll
        for (unsigned j = 0; j < 16; ++j) { const unsigned c = xb_ld(&bar[XB_XCNT(j)]); sum += c; cnt += (c > 0u) ? 1u : 0u; mine = (j == x) ? c : mine; }
        if (sum == G) break;
        __builtin_amdgcn_s_sleep(1);
        if ((++sp & 255u) == 0u) { if (xb_ld(&bar[XB_TMO])) break; if (sp > XB_SPIN_CAP) { atomicAdd(&bar[XB_TMO], 1u); break; } }
    }
    nloc = mine > 0u ? mine : 1u; nx = cnt > 0u ? cnt : 1u;
}
DI void xcd_barrier(unsigned* bar, volatile LAS unsigned* st, int tid) {
    asm volatile("s_waitcnt vmcnt(0) lgkmcnt(0)" ::: "memory");
    __syncthreads();
    if (tid == 0) {
        __builtin_amdgcn_s_waitcnt(0);
        const unsigned x = xb_xcc_id();
        unsigned nloc = st[0], nx = st[1];
        if (nloc == 0u) { xcd_barrier_complete(bar, x, nloc, nx); st[0] = nloc; st[1] = nx; }
        const unsigned old = xb_add(&bar[XB_XSUB(x)], 1u);
        const unsigned gen = old / nloc;
        if (old + 1u == (gen + 1u) * nloc) {
            __builtin_amdgcn_fence(__ATOMIC_RELEASE, "agent");
            asm volatile("s_waitcnt vmcnt(0)" ::: "memory");
            const unsigned og = xb_add(&bar[XB_TOP], 1u);
            const unsigned tg = og / nx;
            if (og + 1u == (tg + 1u) * nx) xb_add(&bar[XB_TOPGEN], 1u);
            else XB_SPIN(xb_ld(&bar[XB_TOPGEN]) == tg, bar);
            __builtin_amdgcn_fence(__ATOMIC_ACQUIRE, "agent");
            xb_add(&bar[XB_XGEN(x)], 1u);
            asm volatile("s_waitcnt vmcnt(0)" ::: "memory");
        } else {
            XB_SPIN(xb_ld(&bar[XB_XGEN(x)]) == gen, bar);
            __builtin_amdgcn_fence(__ATOMIC_ACQUIRE, "agent");
            asm volatile("s_waitcnt vmcnt(0)" ::: "memory");
        }
    }
    __syncthreads();
}

__global__ void __launch_bounds__(NTHREADS, 2) mega(Params p) {
    extern __shared__ __attribute__((aligned(16))) unsigned char smem[];
    cg::grid_group grid = cg::this_grid();
    const int wv = __builtin_amdgcn_readfirstlane((int)(threadIdx.x >> 6));
    KP kp = (KP)__builtin_amdgcn_kernarg_segment_ptr();
    const int lo = kp->lo, hi = kp->hi;
    int ph = 0;
#define PH_BEGIN { if (ph >= lo && ph < hi) { KP pp = kp; asm volatile("" : "+s"(pp)); unsigned char* ws = pp->ws; \
    sq_t* sq = (sq_t*)(ws + OFF_SQ); const float* cs = (const float*)(ws + OFF_COS); const float* sn = (const float*)(ws + OFF_SIN); \
    bf16_t* xb = (bf16_t*)(ws + OFF_XB); bf16_t* zb = (bf16_t*)(ws + U_Z); (void)sq; (void)cs; (void)sn; (void)xb; (void)zb;
#define PH_END if (ph + 1 < hi) { xcd_barrier((unsigned*)(ws + OFF_BAR), bst, TID(wv)); if (REP & 16) xcd_barrier((unsigned*)(ws + OFF_BAR), bst, TID(wv)); } } ++ph; }

    if (hi < 0) grid.sync();
    volatile LAS unsigned* bst = (volatile LAS unsigned*)((LAS unsigned char*)smem + 131072);
    if (hi - lo > 1) {
        const int t0 = TID(wv);
        if (t0 < 2) bst[t0] = 0u;
        __syncthreads();
        if (t0 == 0) (void)xb_add(&((unsigned*)(kp->ws + OFF_BAR))[XB_XCNT(xb_xcc_id())], 1u);
    }

    PH_BEGIN for (int rep = 0; rep < ((REP & 8) ? 2 : 1); ++rep) prologue(wv, pp, ws, smem); PH_END

    for (int L = 0; L < 4; ++L) {
        const int j = L >> 1;
        const bool even = (L & 1) == 0;
        for (int half = 0; half < 2; ++half) {
            if (half == 0) {
                if (even) { if (EN2 & 1) {
                    PH_BEGIN {
                        EpiInEven e{zb, sq + (size_t)L * R, sq + (size_t)(9 + j) * R, sq + (size_t)(11 + j) * R, (bf16_t*)(ws + U_EV_K), cs, sn};
                        if (EN & 2) gemm_phase(wv, smem, xb, 1024, (const bf16_t*)(ws + WT_EVIN) + (size_t)j * EV_IN_PAD * 1024, 0, 1024, R / 256, EV_IN_PAD / 256, e);
                    } PH_END
                    PH_BEGIN {
                        for (int rep = 0; rep < ((REP & 4) ? 2 : 1); ++rep) {
                        EpiQ eq{(bf16_t*)(ws + U_EV_Q), sq + (size_t)(9 + j) * R, cs, sn};
                        if (EN & 4) gemm_phase(wv, smem, zb + 1536, EV_ZLD, (const bf16_t*)(ws + WT_EVQ) + (size_t)j * 768 * 384, 0, 384, R / 256, 3, eq);
                        EpiKV ek{(bf16_t*)(ws + U_EV_K), (bf16_t*)(ws + U_EV_VT), sq + (size_t)(11 + j) * R};
                        if (EN & 8) gemm_phase(wv, smem, zb + 1920, EV_ZLD, (const bf16_t*)(ws + WT_EVKV) + (size_t)j * 1024 * 256, 0, 256, R / 256, 4, ek);
                        if (EN & 16) conv_phase(wv, zb, pp->ev_conv + (size_t)j * 3 * 512, (bf16_t*)(ws + U_EV_MIX)); }
                    } PH_END
                    PH_BEGIN for (int rep = 0; rep < ((REP & 2) ? 2 : 1); ++rep) attn_phase(wv, smem, (const bf16_t*)(ws + U_EV_Q), (const bf16_t*)(ws + U_EV_K), (const bf16_t*)(ws + U_EV_VT), (bf16_t*)(ws + U_EV_MIX)); PH_END
                } } else { if (EN2 & 2) {
                    PH_BEGIN {
                        EpiInOdd e{zb, (float*)(ws + OFF_GLOW), sq + (size_t)L * R};
                        if (EN & 64) gemm_phase(wv, smem, xb, 1024, (const bf16_t*)(ws + WT_ODIN) + (size_t)j * OD_IN_PAD * 1024, 0, 1024, R / 256, OD_IN_PAD / 256, e);
                    } PH_END
                    PH_BEGIN for (int rep = ((REP & 32) ? 0 : 1); rep < 2; ++rep) gla_prep(wv, rep == 0, smem, zb, (const float*)(ws + OFF_GLOW), pp->od_wg2 + (size_t)j * 16 * 512, pp->od_bg2 + (size_t)j * 512, (bf16_t*)(ws + U_OD_KLT), (bf16_t*)(ws + U_OD_AT), (float*)(ws + U_OD_DEC)); PH_END
                    PH_BEGIN for (int rep = ((REP & 64) ? 0 : 1); rep < 2; ++rep) gla_scan(wv, rep == 0, smem, zb, (const bf16_t*)(ws + U_OD_KLT), (const bf16_t*)(ws + U_OD_AT), (const float*)(ws + U_OD_DEC), sq + (size_t)(13 + 4 * j) * R); PH_END
                    PH_BEGIN for (int rep = ((REP & 128) ? 0 : 1); rep < 2; ++rep) gla_gate(wv, zb, sq + (size_t)(13 + 4 * j) * R, pp->od_og + (size_t)j * 256, (bf16_t*)(ws + U_OD_MIX)); PH_END
                } }
            } else if (EN2 & 4) {
                PH_BEGIN {
                    EpiMlp1 e{(bf16_t*)(ws + U_HID), sq + (size_t)(((even ? (EN2 & 1) : (EN2 & 2)) ? 4 + L : L)) * R};
                    for (int rep = 0; rep < ((REP & 1) ? 2 : 1); ++rep) gemm_phase(wv, smem, xb, 1024, (const bf16_t*)(ws + WT_W1) + (size_t)L * 4096 * 1024, 0, 1024, R / 256, 16, e);
                } PH_END
            }
            if (half == 0 ? (even ? (EN2 & 1) : (EN2 & 2)) : (EN2 & 4)) PH_BEGIN {
                const bf16_t* A; const bf16_t* Bt; int K; sq_t* sqn;
                if (half == 0) {
                    A = (const bf16_t*)(ws + (even ? U_EV_MIX : U_OD_MIX));
                    Bt = (const bf16_t*)(ws + (even ? WT_EVOUT : WT_ODOUT)) + (size_t)j * 1024 * 1024; K = 1024; sqn = sq + (size_t)(4 + L) * R;
                } else {
                    A = (const bf16_t*)(ws + U_HID); Bt = (const bf16_t*)(ws + WT_W2) + (size_t)L * 1024 * 4096; K = 4096; sqn = (L < 3) ? sq + (size_t)(L + 1) * R : sq + (size_t)8 * R;
                }
                const float* xin = (!XCOPY && L == 0 && half == 0) ? pp->x : pp->out;
                EpiResid e{xin, pp->out, xb, sqn, !(L == 3 && half == 1)};
                if (EN & 2048) gemm_phase(wv, smem, A, K, Bt, half, K, R / 256, 4, e);
            } PH_END
        }
    }
    PH_BEGIN if (EN & 4096) final_phase(wv, pp->out, sq + (size_t)8 * R, pp->fin_g); PH_END
}
constexpr int N_PHASES = 1 + 2 * 6 + 2 * 7 + 1;

extern "C" void kernel_launch(void* const* d_in, const int* in_sizes, int n_in, void* d_out, int out_size, void* d_ws, size_t ws_size, hipStream_t stream) {
    static int grid_blocks = 0;
    if (grid_blocks == 0) {
        if (n_in != 19 || ws_size < WS_NEED) { fprintf(stderr, "kernel_launch: need 19 inputs and %zu bytes of workspace, got %d and %zu\n", (size_t)WS_NEED, n_in, ws_size); grid_blocks = -1; return; }
        int dev = 0, cus = 0, per_cu = 0;
        hipGetDevice(&dev);
        hipDeviceGetAttribute(&cus, hipDeviceAttributeMultiprocessorCount, dev);
        if (hipFuncSetAttribute((const void*)mega, hipFuncAttributeMaxDynamicSharedMemorySize, LDS_BYTES) != hipSuccess) { fprintf(stderr, "kernel_launch: hipFuncSetAttribute failed\n"); grid_blocks = -1; return; }
        if (hipOccupancyMaxActiveBlocksPerMultiprocessor(&per_cu, (const void*)mega, NTHREADS, LDS_BYTES) != hipSuccess || per_cu < 1) { fprintf(stderr, "kernel_launch: occupancy query says %d\n", per_cu); per_cu = 1; (void)hipGetLastError(); }
        grid_blocks = cus * per_cu;
    }
    if (grid_blocks < 0) return;
    Params p{};
    p.x = (const float*)d_in[0]; p.pos = (const int*)d_in[1]; p.mix_g = (const float*)d_in[2]; p.mlp_g = (const float*)d_in[3]; p.fin_g = (const float*)d_in[4];
    p.ev_w_in = (const float*)d_in[5]; p.ev_conv = (const float*)d_in[6]; p.ev_qg = (const float*)d_in[7]; p.ev_wqb = (const float*)d_in[8]; p.ev_kvg = (const float*)d_in[9];
    p.ev_wkvb = (const float*)d_in[10]; p.ev_wout = (const float*)d_in[11]; p.od_w_in = (const float*)d_in[12]; p.od_wg2 = (const float*)d_in[13]; p.od_bg2 = (const float*)d_in[14];
    p.od_og = (const float*)d_in[15]; p.od_wout = (const float*)d_in[16]; p.w1 = (const float*)d_in[17]; p.w2 = (const float*)d_in[18];
    p.out = (float*)d_out; p.ws = (unsigned char*)d_ws;
#if MULTI_LAUNCH
    for (int k = 0; k < N_PHASES; ++k) {
        p.lo = k; p.hi = k + 1;
        hipLaunchKernelGGL(mega, dim3(grid_blocks), dim3(NTHREADS), LDS_BYTES, stream, p);
    }
#else
    p.lo = 0; p.hi = N_PHASES;
    if (hipMemsetAsync((unsigned char*)d_ws + OFF_BAR, 0, 16384, stream) != hipSuccess) { fprintf(stderr, "kernel_launch: memset of barrier words failed\n"); return; }
    void* args[] = {&p};
    hipError_t e = hipLaunchCooperativeKernel((const void*)mega, dim3(grid_blocks), dim3(NTHREADS), args, LDS_BYTES, stream);
    if (e != hipSuccess) fprintf(stderr, "cooperative launch failed: %s (grid %d)\n", hipGetErrorString(e), grid_blocks);
#endif
}
```

```cpp
#include <hip/hip_runtime.h>
#include <hip/hip_cooperative_groups.h>
#include <hip/amd_detail/amd_hip_unsafe_atomics.h>
#include <cstdio>
#include <cstdint>
namespace cg = cooperative_groups;

#ifndef EN
#define EN 0xffff
#endif
#ifndef REP
#define REP 0
#endif
#ifndef EN2
#define EN2 7
#define XCOPY 0
#endif
#ifndef MULTI_LAUNCH
#define MULTI_LAUNCH 0
#endif

typedef unsigned short bf16_t;
typedef short bf16x8 __attribute__((ext_vector_type(8)));
typedef short s16x4 __attribute__((ext_vector_type(4)));
typedef float f32x4 __attribute__((ext_vector_type(4)));
typedef float f32x16 __attribute__((ext_vector_type(16)));
typedef unsigned u32x4 __attribute__((ext_vector_type(4)));
typedef unsigned u32x2 __attribute__((ext_vector_type(2)));
#define DI __device__ __forceinline__

constexpr int R = 32768;
constexpr int SEQ = 4096;
constexpr int DM = 1024;
constexpr int DFF = 4096;
constexpr int EV_IN = 2208, EV_IN_PAD = 2304, EV_ZLD = 2176;
constexpr int OD_IN = 3088, OD_IN_PAD = 3328, OD_ZLD = 3072;
constexpr float EPS = 1e-6f;
constexpr float QSCALE = 0.10206207261596575f * 1.4426950408889634f;
constexpr float GLA_QSCALE = 0.08838834764831845f;
constexpr int NTHREADS = 512;
constexpr int LDS_BYTES = 131072 + 64;

constexpr size_t WT_EVIN = 0;
constexpr size_t WT_EVQ = WT_EVIN + (size_t)2 * EV_IN_PAD * 1024 * 2;
constexpr size_t WT_EVKV = WT_EVQ + (size_t)2 * 768 * 384 * 2;
constexpr size_t WT_EVOUT = WT_EVKV + (size_t)2 * 1024 * 256 * 2;
constexpr size_t WT_ODIN = WT_EVOUT + (size_t)2 * 1024 * 1024 * 2;
constexpr size_t WT_ODOUT = WT_ODIN + (size_t)2 * OD_IN_PAD * 1024 * 2;
constexpr size_t WT_W1 = WT_ODOUT + (size_t)2 * 1024 * 1024 * 2;
constexpr size_t WT_W2 = WT_W1 + (size_t)4 * 4096 * 1024 * 2;
constexpr size_t OFF_XB = WT_W2 + (size_t)4 * 4096 * 1024 * 2;
constexpr size_t OFF_SQ = OFF_XB + (size_t)R * 1024 * 2;
constexpr size_t SQ_FLOATS = (size_t)21 * R;
constexpr size_t OFF_COS = OFF_SQ + SQ_FLOATS * 8;
constexpr size_t OFF_SIN = OFF_COS + (size_t)R * 16 * 4;
constexpr size_t OFF_GLOW = OFF_SIN + (size_t)R * 16 * 4;
constexpr size_t OFF_BAR = OFF_GLOW + (size_t)R * 16 * 4;
constexpr size_t OFF_U = OFF_BAR + 16384;
constexpr size_t U_HID = OFF_U;
constexpr size_t U_Z = OFF_U;
constexpr size_t U_EV_MIX = OFF_U + (size_t)R * EV_ZLD * 2;
constexpr size_t U_EV_Q = U_EV_MIX + (size_t)R * 1024 * 2;
constexpr size_t U_EV_K = U_EV_Q + (size_t)64 * 4096 * 96 * 2;
constexpr size_t U_EV_VT = U_EV_K + (size_t)64 * 4096 * 96 * 2;
constexpr size_t U_EV_END = U_EV_VT + (size_t)64 * 64 * 4096 * 2;
constexpr size_t U_OD_MIX = OFF_U + (size_t)R * OD_ZLD * 2;
constexpr size_t U_OD_KLT = U_OD_MIX + (size_t)R * 1024 * 2;
constexpr size_t U_OD_AT = U_OD_KLT + (size_t)2048 * 128 * 64 * 2;
constexpr size_t U_OD_DEC = U_OD_AT + (size_t)2048 * 64 * 64 * 2;
constexpr size_t U_OD_END = U_OD_DEC + (size_t)2048 * 128 * 4;
constexpr size_t U_HID_END = U_HID + (size_t)R * 4096 * 2;
constexpr size_t WS_NEED = (U_EV_END > U_OD_END ? (U_EV_END > U_HID_END ? U_EV_END : U_HID_END) : (U_OD_END > U_HID_END ? U_OD_END : U_HID_END));

struct Params {
    const float* x; const int* pos; const float* mix_g; const float* mlp_g; const float* fin_g;
    const float* ev_w_in; const float* ev_conv; const float* ev_qg; const float* ev_wqb; const float* ev_kvg; const float* ev_wkvb; const float* ev_wout;
    const float* od_w_in; const float* od_wg2; const float* od_bg2; const float* od_og; const float* od_wout;
    const float* w1; const float* w2;
    float* out; unsigned char* ws; int lo, hi;
};

DI unsigned pk2(float a, float b) {
    typedef __bf16 bf2 __attribute__((ext_vector_type(2)));
    bf2 v; v.x = (__bf16)a; v.y = (__bf16)b; return __builtin_bit_cast(unsigned, v);
}
DI bf16_t f2bf(float a) { __bf16 v = (__bf16)a; return __builtin_bit_cast(bf16_t, v); }
DI float bf2f(bf16_t u) { return __uint_as_float(((unsigned)u) << 16); }
DI float bflo(unsigned u) { return __uint_as_float(u << 16); }
DI float bfhi(unsigned u) { return __uint_as_float(u & 0xffff0000u); }
DI void st_bf4(bf16_t* p, f32x4 v) { u32x2 w; w.x = pk2(v[0], v[1]); w.y = pk2(v[2], v[3]); *(u32x2*)p = w; }
DI int TID(int wv) { int lane; asm volatile("v_mbcnt_lo_u32_b32 %0, -1, 0\n\tv_mbcnt_hi_u32_b32 %0, -1, %0" : "=v"(lane)); asm volatile("" : "+s"(wv)); return wv * 64 + lane; }
DI int BID() { int b = blockIdx.x; asm volatile("" : "+s"(b)); return b; }
DI int GDIM() { int g = gridDim.x; asm volatile("" : "+s"(g)); return g; }
DI void st_bf8_sw(bf16_t* p32, f32x4 v0, f32x4 v1, int fq) {
    const unsigned a0 = pk2(v0[0], v0[1]), a1 = pk2(v0[2], v0[3]), b0 = pk2(v1[0], v1[1]), b1 = pk2(v1[2], v1[3]);
    const auto r0 = __builtin_amdgcn_permlane16_swap(a0, b0, false, false);
    const auto r1 = __builtin_amdgcn_permlane16_swap(a1, b1, false, false);
    u32x4 w; w.x = r0[0]; w.y = r1[0]; w.z = r0[1]; w.w = r1[1];
    *(u32x4*)(p32 + 8 * (fq >> 1) + 16 * (fq & 1)) = w;
}
DI void st_bf8_sw32(bf16_t* p16, f32x4 ga, f32x4 gb, int h) {
    const unsigned a0 = pk2(ga[0], ga[1]), a1 = pk2(ga[2], ga[3]), b0 = pk2(gb[0], gb[1]), b1 = pk2(gb[2], gb[3]);
    const auto r0 = __builtin_amdgcn_permlane32_swap(a0, b0, false, false);
    const auto r1 = __builtin_amdgcn_permlane32_swap(a1, b1, false, false);
    u32x4 w; w.x = r0[0]; w.y = r1[0]; w.z = r0[1]; w.w = r1[1];
    *(u32x4*)(p16 + 8 * h) = w;
}
DI int crow(int reg, int h) { return (reg & 3) + 8 * (reg >> 2) + 4 * h; }
#define MFMA32(a, b, c) __builtin_amdgcn_mfma_f32_32x32x16_bf16((a), (b), (c), 0, 0, 0)
#define MFMA16(a, b, c) __builtin_amdgcn_mfma_f32_16x16x32_bf16((a), (b), (c), 0, 0, 0)
DI bf16x8 pack8(const f32x16& x, int s) {
    u32x4 p; p.x = pk2(x[8 * s], x[8 * s + 1]); p.y = pk2(x[8 * s + 2], x[8 * s + 3]); p.z = pk2(x[8 * s + 4], x[8 * s + 5]); p.w = pk2(x[8 * s + 6], x[8 * s + 7]);
    return __builtin_bit_cast(bf16x8, p);
}

constexpr int BM = 256, BK = 64, HALF = 128, NXCD = 8, WGM = 8, HT = HALF * BK;
DI int lds_byte(int r, int c) { int st = (r >> 4) * 2 + (c >> 5), rr = r & 15, cc = c & 31, ob = rr * 64 + cc * 2; return st * 1024 + (ob ^ (((ob >> 9) & 1) << 5)); }
DI void stage_rc(int b, int& Rr, int& Cc) { int st = b / 1024, sb = b % 1024, swz = sb ^ (((sb >> 9) & 1) << 5); Rr = (st >> 1) * 16 + swz / 64; Cc = (st & 1) * 32 + (swz % 64) / 2; }

#define LAS __attribute__((address_space(3)))
template <class Epi>
DI void gemm_phase(int wv, unsigned char* smem, const bf16_t* __restrict__ A, int lda, const bf16_t* __restrict__ Bt  , int rev  , int K, int nM, int nN, const Epi& epi) {
    LAS unsigned char* lds = (LAS unsigned char*)smem;
    const int tid = TID(wv); const int bid = BID(), gdim = GDIM();
    const int wid = __builtin_amdgcn_readfirstlane(tid >> 6), lane = tid & 63, wr = wid >> 2, wc = wid & 3, fr = lane & 15, fq = lane >> 4;
    const int nwg = nM * nN, nt = K / BK, ldb = nN * BM;
    unsigned voffA[2], voffB[2];
#pragma unroll
    for (int i = 0; i < 2; ++i) { int r_, c_; stage_rc(tid * 16 + i * 8192, r_, c_); voffA[i] = (unsigned)(r_ * lda + c_) * 2u;
        const unsigned b_ = (unsigned)(tid * 16 + i * 8192), krow = b_ >> 8, chp = (b_ >> 4) & 15u, ch = chp ^ (((krow & 3u) << 2) | ((krow >> 2) & 3u));
        voffB[i] = (krow * (unsigned)ldb + ch * 8u) * 2u; }
    const size_t kstep = (size_t)(BK * 2), kstepB = (size_t)BK * ldb * 2;
    const size_t hstepA = (size_t)HALF * lda * 2, hstepB = (size_t)HALF * 2;
    const unsigned ldsw = (unsigned)wid * 1024u;
    const int aoff = lds_byte(wr * 64 + fr, fq * 8);
    unsigned trb[2][2];
    { const unsigned gq = (unsigned)fq, q = (unsigned)(fr >> 2), p = (unsigned)(fr & 3);
#pragma unroll
      for (int n = 0; n < 2; ++n)
#pragma unroll
          for (int t = 0; t < 2; ++t)
              trb[n][t] = (unsigned)(size_t)lds + 256u * (8u * gq + 4u * t + q) + 16u * (4u * ((unsigned)wc ^ q) + 2u * ((unsigned)n ^ (gq & 1u)) + ((p >> 1) ^ (unsigned)t)) + 8u * (p & 1u); }
    constexpr int HTB = HALF * BK * 2;
#define G_SA(b, h) ((4 + (b) * 2 + (h)) * HTB)
#define G_SB(b, h) (((b) * 2 + (h)) * HTB)
#define G_STAGE(bufoff, gbase, voff) do { const char* _ub = (gbase); asm volatile("" : "+s"(_ub)); _Pragma("unroll") for (int _i = 0; _i < 2; ++_i) \
        __builtin_amdgcn_global_load_lds((const unsigned*)(_ub + (voff)[_i]), (LAS unsigned*)(lds + (bufoff) + ldsw + _i * 8192), 16, 0, 0); } while (0)
#define G_LDA(dst, b, h) do { _Pragma("unroll") for (int m = 0; m < 4; ++m) _Pragma("unroll") for (int k = 0; k < 2; ++k) dst[m][k] = *(const LAS bf16x8*)(lds + G_SA(b, h) + aoff + m * 2048 + k * 1024); } while (0)
#define G_TR(dst_, addr_, imm_) asm volatile("ds_read_b64_tr_b16 %0, %1 offset:%2" : "=v"(dst_) : "v"(addr_), "n"(imm_) : "memory")
#define G_LDB(dst, b, h) do { _Pragma("unroll") for (int n = 0; n < 2; ++n) _Pragma("unroll") for (int k = 0; k < 2; ++k) _Pragma("unroll") for (int t = 0; t < 2; ++t) { \
        if (k == 0) G_TR(dst[n][k][t], trb[n][t], G_SB(b, h)); else G_TR(dst[n][k][t], trb[n][t], G_SB(b, h) + 8192); } } while (0)
#define G_FRAG(x) __builtin_bit_cast(bf16x8, __builtin_shufflevector((x)[0], (x)[1], 0, 1, 2, 3))
#define G_MMA(ai, bj, At_, Bt_) do { __builtin_amdgcn_s_setprio(1); _Pragma("unroll") for (int m = 0; m < 4; ++m) _Pragma("unroll") for (int n = 0; n < 2; ++n) _Pragma("unroll") for (int k = 0; k < 2; ++k) \
        acc[ai][bj][m][n] = MFMA16(G_FRAG(Bt_[n][k]), At_[m][k], acc[ai][bj][m][n]); __builtin_amdgcn_s_setprio(0); } while (0)
#define G_WAIT_V(n) asm volatile("s_waitcnt vmcnt(" #n ")" ::: "memory")
#define G_WAIT_L(n) asm volatile("s_waitcnt lgkmcnt(" #n ")" ::: "memory")
#define G_WAIT_LB() asm volatile("s_waitcnt lgkmcnt(0)" : "+v"(B0[0][0][0]), "+v"(B0[0][0][1]), "+v"(B0[0][1][0]), "+v"(B0[0][1][1]), "+v"(B0[1][0][0]), "+v"(B0[1][0][1]), "+v"(B0[1][1][0]), "+v"(B0[1][1][1]), \
        "+v"(B1[0][0][0]), "+v"(B1[0][0][1]), "+v"(B1[0][1][0]), "+v"(B1[0][1][1]), "+v"(B1[1][0][0]), "+v"(B1[1][0][1]), "+v"(B1[1][1][0]), "+v"(B1[1][1][1]) :: "memory")
#define G_BAR __builtin_amdgcn_s_barrier()
#define G_SCHED __builtin_amdgcn_sched_barrier(0)
#define TILE_RC(T_, BR_, BC_) do { int wgid = (T_); \
        { int q = nwg / NXCD, r = nwg % NXCD, xcd = wgid % NXCD, off = wgid / NXCD; if (rev && r == 0) off = q - 1 - off; wgid = (xcd < r ? xcd * (q + 1) : r * (q + 1) + (xcd - r) * q) + off; } \
        const int nig = WGM * nN, gid = wgid / nig, fm = gid * WGM, gsz = min(nM - fm, WGM); \
        BR_ = (fm + ((wgid % nig) % gsz)) * BM; BC_ = ((wgid % nig) / gsz) * BM; } while (0)
    int tile = bid;
    if (tile >= nwg) return;
    int brow, bcol; TILE_RC(tile, brow, bcol);
    f32x4 acc[2][2][4][2];
#pragma unroll
    for (int a = 0; a < 2; ++a)
#pragma unroll
        for (int b = 0; b < 2; ++b)
#pragma unroll
            for (int m = 0; m < 4; ++m)
#pragma unroll
                for (int n = 0; n < 2; ++n) acc[a][b][m][n] = (f32x4){0.f, 0.f, 0.f, 0.f};
    bf16x8 At[4][2]; u32x2 B0[2][2][2], B1[2][2][2];
    const char* cA = (const char*)A + (size_t)brow * lda * 2; const char* cB = (const char*)Bt + (size_t)bcol * 2;
    G_STAGE(G_SB(0, 0), cB, voffB); G_STAGE(G_SB(0, 1), cB + hstepB, voffB); G_STAGE(G_SA(0, 0), cA, voffA); G_STAGE(G_SA(0, 1), cA + hstepA, voffA);
    if (wr == 1) G_BAR;
    G_WAIT_V(2); G_BAR;
    G_STAGE(G_SB(1, 0), cB + kstepB, voffB); G_STAGE(G_SA(1, 0), cA + kstep, voffA); G_STAGE(G_SB(1, 1), cB + hstepB + kstepB, voffB);
    G_WAIT_V(6); G_BAR;
    for (;;) {
        const int ntile = tile + gdim; const bool has_next = ntile < nwg;
        int nbrow = brow, nbcol = bcol; if (has_next) TILE_RC(ntile, nbrow, nbcol);
        const char* nA = has_next ? (const char*)A + (size_t)nbrow * lda * 2 : cA; const char* nB = has_next ? (const char*)Bt + (size_t)nbcol * 2 : cB;
        for (int t = 0; t < nt; t += 2) {
            const bool last = (t == nt - 2);
            const char* a1 = cA + (size_t)(t + 1) * kstep;
            const char* a2 = last ? nA : cA + (size_t)(t + 2) * kstep; const char* b2 = last ? nB : cB + (size_t)(t + 2) * kstepB;
            const char* a3 = a2 + kstep; const char* b3 = b2 + kstepB;
            G_LDB(B0, 0, 0); G_LDB(B1, 0, 1); G_SCHED; G_LDA(At, 0, 0); G_STAGE(G_SA(1, 1), a1 + hstepA, voffA);
            G_WAIT_V(8); G_WAIT_LB(); G_BAR; G_MMA(0, 0, At, B0); G_MMA(0, 1, At, B1); G_BAR; G_SCHED;
            G_LDA(At, 0, 1); G_STAGE(G_SB(0, 0), b2, voffB); G_STAGE(G_SB(0, 1), b2 + hstepB, voffB); G_STAGE(G_SA(0, 0), a2, voffA);
            G_WAIT_V(8); G_WAIT_L(0); G_BAR; G_MMA(1, 0, At, B0); G_MMA(1, 1, At, B1); G_BAR; G_SCHED;
            G_LDB(B0, 1, 0); G_LDB(B1, 1, 1); G_SCHED; G_LDA(At, 1, 0); G_STAGE(G_SA(0, 1), a2 + hstepA, voffA);
            G_WAIT_V(8); G_WAIT_LB(); G_BAR; G_MMA(0, 0, At, B0); G_MMA(0, 1, At, B1); G_BAR; G_SCHED;
            G_LDA(At, 1, 1); G_STAGE(G_SB(1, 0), b3, voffB); G_STAGE(G_SB(1, 1), b3 + hstepB, voffB); G_STAGE(G_SA(1, 0), a3, voffA);
            G_WAIT_V(8); G_WAIT_L(0); G_BAR; G_MMA(1, 0, At, B0); G_MMA(1, 1, At, B1); G_BAR; G_SCHED;
        }
        if (wr == 0) G_BAR;
        { const int t2 = TID(wv); const int l2 = t2 & 63, w2 = t2 >> 6; epi(acc, brow, bcol, w2 >> 2, w2 & 3, l2 & 15, l2 >> 4); }
        if (!has_next) break;
#pragma unroll
        for (int a = 0; a < 2; ++a)
#pragma unroll
            for (int b = 0; b < 2; ++b)
#pragma unroll
                for (int m = 0; m < 4; ++m)
#pragma unroll
                    for (int n = 0; n < 2; ++n) acc[a][b][m][n] = (f32x4){0.f, 0.f, 0.f, 0.f};
        tile = ntile; brow = nbrow; bcol = nbcol; cA = nA; cB = nB;
        if (wr == 1) G_BAR;
    }
    G_WAIT_V(0);
    G_BAR;
}

#define EROW(ai, m) (brow + (ai) * 128 + wr * 64 + (m) * 16 + fr)
#define ECOL(bj, n) (bcol + (bj) * 128 + wc * 32 + (n) * 16 + fq * 4)
typedef unsigned long long sq_t;
DI void sq_add(sq_t* p, float v) { atomicAdd(p, (sq_t)(v * 16777216.0f)); }
DI float sq_get(const sq_t* p) { return (float)(long long)(*p) * (1.0f / 16777216.0f); }
DI sq_t sq_raw(const sq_t* p) { return *p; }
DI float sq_cvt(sq_t v) { return (float)(long long)v * (1.0f / 16777216.0f); }
DI float shx(float v, int mask, int lane) { return __int_as_float(__builtin_amdgcn_ds_bpermute((lane ^ mask) << 2, __float_as_int(v))); }
DI float shx32(float v, int lane) {
    const unsigned u = (unsigned)__float_as_int(v);
    const auto r = __builtin_amdgcn_permlane32_swap(u, u, false, false);
    return __int_as_float((int)((lane & 32) ? r[0] : r[1]));
}
DI float shx16(float v, int lane) {
    const unsigned u = (unsigned)__float_as_int(v);
    const auto r = __builtin_amdgcn_permlane16_swap(u, u, false, false);
    return __int_as_float((int)((lane & 16) ? r[0] : r[1]));
}
DI float red_fq(float v, int lane) { v += shx16(v, lane); v += shx32(v, lane); return v; }
DI float dot4(f32x4 v) { return v[0] * v[0] + v[1] * v[1] + v[2] * v[2] + v[3] * v[3]; }

struct EpiInEven {
    bf16_t* z; const sq_t* sq_in; sq_t* sq_q; sq_t* sq_kv; bf16_t* Kb; const float* cs; const float* sn;
    DI void operator()(f32x4 (&acc)[2][2][4][2], int brow, int bcol, int wr, int wc, int fr, int fq) const {
        sq_t rsq[2][4];
#pragma unroll
        for (int ai = 0; ai < 2; ++ai)
#pragma unroll
            for (int m = 0; m < 4; ++m) rsq[ai][m] = sq_raw(sq_in + EROW(ai, m));
        const bool has_norm = bcol >= 1536;
        const bool rope = (bcol == 2048 && wc == 0);
#pragma unroll
        for (int ai = 0; ai < 2; ++ai) {
            asm volatile("" ::: "memory");
            f32x4 c4v[4], s4v[4];
            if (rope) {
#pragma unroll
                for (int m = 0; m < 4; ++m) { c4v[m] = *(const f32x4*)(cs + (unsigned)EROW(ai, m) * 16 + fq * 4); s4v[m] = *(const f32x4*)(sn + (unsigned)EROW(ai, m) * 16 + fq * 4); }
            }
#pragma unroll
            for (int m = 0; m < 4; ++m) {
                const int row = EROW(ai, m);
                const float rs = rsqrtf(sq_cvt(rsq[ai][m]) * (1.0f / 1024.0f) + EPS);
                float aq = 0.f, akv = 0.f;
#pragma unroll
                for (int bj = 0; bj < 2; ++bj) {
                    const int c32 = bcol + bj * 128 + wc * 32;
                    const f32x4 v0 = acc[ai][bj][m][0] * rs, v1 = acc[ai][bj][m][1] * rs;
                    if (c32 < EV_ZLD) st_bf8_sw(z + (unsigned)row * EV_ZLD + c32, v0, v1, fq);
                    if (has_norm) { const float ss = dot4(v0) + dot4(v1); if (c32 >= 1536 && c32 < 1920) aq += ss; else if (c32 >= 1920 && c32 < 2176) akv += ss; }
                }
                if (has_norm) {
                    aq = red_fq(aq, fq * 16 + fr); akv = red_fq(akv, fq * 16 + fr);
                    if (fq == 0) { if (bcol < 2048) sq_add(sq_q + row, aq); if (bcol >= 1792) sq_add(sq_kv + row, akv); }
                }
                if (rope) {
                    const f32x4 t1 = acc[ai][1][m][0] * rs, t2 = acc[ai][1][m][1] * rs;
                    const f32x4 c4 = c4v[m], s4 = s4v[m];
                    const f32x4 o1 = t1 * c4 - t2 * s4, o2 = t2 * c4 + t1 * s4;
                    const int b = row >> 12, s = row & 4095;
#pragma unroll
                    for (int hh = 0; hh < 8; ++hh) st_bf8_sw(Kb + ((unsigned)(b * 8 + hh) * 4096 + s) * 96 + 64, o1, o2, fq);
                }
            }
        }
    }
};
struct EpiQ {
    bf16_t* Qb; const sq_t* sq; const float* cs; const float* sn;
    DI void operator()(f32x4 (&acc)[2][2][4][2], int brow, int bcol, int wr, int wc, int fr, int fq) const {
        sq_t rsq[2][4];
#pragma unroll
        for (int ai = 0; ai < 2; ++ai)
#pragma unroll
            for (int m = 0; m < 4; ++m) rsq[ai][m] = sq_raw(sq + EROW(ai, m));
        const bool rope0 = ((bcol + wc * 32) % 96) == 64, rope1 = ((bcol + 128 + wc * 32) % 96) == 64;
#pragma unroll
        for (int ai = 0; ai < 2; ++ai) {
            asm volatile("" ::: "memory");
            f32x4 c4v[4], s4v[4];
            if (rope0 || rope1) {
#pragma unroll
                for (int m = 0; m < 4; ++m) { c4v[m] = *(const f32x4*)(cs + (unsigned)EROW(ai, m) * 16 + fq * 4); s4v[m] = *(const f32x4*)(sn + (unsigned)EROW(ai, m) * 16 + fq * 4); }
            }
#pragma unroll
            for (int m = 0; m < 4; ++m) {
                const int row = EROW(ai, m);
                const float rs = rsqrtf(sq_cvt(rsq[ai][m]) * (1.0f / 384.0f) + EPS) * QSCALE;
                const int b = row >> 12, s = row & 4095;
#pragma unroll
                for (int bj = 0; bj < 2; ++bj) {
                    const int c32 = bcol + bj * 128 + wc * 32; const int hh = c32 / 96, d32 = c32 - hh * 96;
                    f32x4 v0 = acc[ai][bj][m][0] * rs, v1 = acc[ai][bj][m][1] * rs;
                    if (d32 == 64) {
                        const f32x4 c4 = c4v[m], s4 = s4v[m];
                        const f32x4 o1 = v0 * c4 - v1 * s4, o2 = v1 * c4 + v0 * s4; v0 = o1; v1 = o2;
                    }
                    st_bf8_sw(Qb + ((unsigned)(b * 8 + hh) * 4096 + s) * 96 + d32, v0, v1, fq);
                }
            }
        }
    }
};
struct EpiKV {
    bf16_t* Kb; bf16_t* Vt; const sq_t* sq;
    DI void operator()(f32x4 (&acc)[2][2][4][2], int brow, int bcol, int wr, int wc, int fr, int fq) const {
        sq_t rsq[2][4];
#pragma unroll
        for (int ai = 0; ai < 2; ++ai)
#pragma unroll
            for (int m = 0; m < 4; ++m) rsq[ai][m] = sq_raw(sq + EROW(ai, m));
#pragma unroll
        for (int ai = 0; ai < 2; ++ai)
#pragma unroll
            for (int m = 0; m < 4; ++m) {
                asm volatile("" ::: "memory");
                const int row = EROW(ai, m);
                const float rs = rsqrtf(sq_cvt(rsq[ai][m]) * (1.0f / 256.0f) + EPS);
                const int b = row >> 12, s = row & 4095;
#pragma unroll
                for (int bj = 0; bj < 2; ++bj) {
                    const int c32 = bcol + bj * 128 + wc * 32; const int hh = c32 >> 7, r32 = c32 & 127;
                    if (r32 < 64) st_bf8_sw(Kb + ((unsigned)(b * 8 + hh) * 4096 + s) * 96 + r32, acc[ai][bj][m][0] * rs, acc[ai][bj][m][1] * rs, fq);
                    else {
#pragma unroll
                        for (int n = 0; n < 2; ++n) {
                            const f32x4 v = acc[ai][bj][m][n] * rs; const int rr = r32 + n * 16 + fq * 4;
                            bf16_t* p = Vt + ((unsigned)(b * 8 + hh) * 64 + (rr - 64)) * 4096 + s; p[0] = f2bf(v[0]); p[4096] = f2bf(v[1]); p[8192] = f2bf(v[2]); p[12288] = f2bf(v[3]);
                        }
                    }
                }
            }
    }
};
struct EpiResid {
    const float* xin; float* xout; bf16_t* xb; sq_t* sq_next; bool wxb;
    DI void operator()(f32x4 (&acc)[2][2][4][2], int brow, int bcol, int wr, int wc, int fr, int fq) const {
#pragma unroll
        for (int ai = 0; ai < 2; ++ai) {
            asm volatile("" ::: "memory");
            f32x4 xv[4][2][2];
#pragma unroll
            for (int m = 0; m < 4; ++m)
#pragma unroll
                for (int bj = 0; bj < 2; ++bj)
#pragma unroll
                    for (int n = 0; n < 2; ++n) xv[m][bj][n] = *(const f32x4*)(xin + (unsigned)EROW(ai, m) * 1024 + ECOL(bj, n));
#pragma unroll
            for (int m = 0; m < 4; ++m) {
                const int row = EROW(ai, m); float ss = 0.f;
#pragma unroll
                for (int bj = 0; bj < 2; ++bj) {
                    const unsigned p0 = (unsigned)row * 1024u + (unsigned)ECOL(bj, 0);
                    const f32x4 v0 = xv[m][bj][0] + acc[ai][bj][m][0], v1 = xv[m][bj][1] + acc[ai][bj][m][1];
                    *(f32x4*)(xout + p0) = v0; *(f32x4*)(xout + p0 + 16) = v1; ss += dot4(v0); ss += dot4(v1);
                    if (wxb) st_bf8_sw(xb + (unsigned)row * 1024u + bcol + bj * 128 + wc * 32, v0, v1, fq);
                }
                ss = red_fq(ss, fq * 16 + fr);
                if (fq == 0) sq_add(sq_next + row, ss);
            }
        }
    }
};
struct EpiMlp1 {
    bf16_t* hid; const sq_t* sq;
    DI void operator()(f32x4 (&acc)[2][2][4][2], int brow, int bcol, int wr, int wc, int fr, int fq) const {
        sq_t rsq[2][4];
#pragma unroll
        for (int ai = 0; ai < 2; ++ai)
#pragma unroll
            for (int m = 0; m < 4; ++m) rsq[ai][m] = sq_raw(sq + EROW(ai, m));
#pragma unroll
        for (int ai = 0; ai < 2; ++ai)
#pragma unroll
            for (int m = 0; m < 4; ++m) {
                asm volatile("" ::: "memory");
                const int row = EROW(ai, m);
                const float rs = rsqrtf(sq_cvt(rsq[ai][m]) * (1.0f / 1024.0f) + EPS);
#pragma unroll
                for (int bj = 0; bj < 2; ++bj) {
                    f32x4 v0 = acc[ai][bj][m][0] * rs, v1 = acc[ai][bj][m][1] * rs;
#pragma unroll
                    for (int e = 0; e < 4; ++e) { const float t0 = fmaxf(v0[e], 0.f), t1 = fmaxf(v1[e], 0.f); v0[e] = t0 * t0; v1[e] = t1 * t1; }
                    st_bf8_sw(hid + (unsigned)row * DFF + bcol + bj * 128 + wc * 32, v0, v1, fq);
                }
            }
    }
};
struct EpiInOdd {
    bf16_t* z; float* glow; const sq_t* sq_in;
    DI void operator()(f32x4 (&acc)[2][2][4][2], int brow, int bcol, int wr, int wc, int fr, int fq) const {
        sq_t rsq[2][4];
#pragma unroll
        for (int ai = 0; ai < 2; ++ai)
#pragma unroll
            for (int m = 0; m < 4; ++m) rsq[ai][m] = sq_raw(sq_in + EROW(ai, m));
#pragma unroll
        for (int ai = 0; ai < 2; ++ai)
#pragma unroll
            for (int m = 0; m < 4; ++m) {
                asm volatile("" ::: "memory");
                const int row = EROW(ai, m);
                const float rs = rsqrtf(sq_cvt(rsq[ai][m]) * (1.0f / 1024.0f) + EPS);
#pragma unroll
                for (int bj = 0; bj < 2; ++bj) {
                    const int c32 = bcol + bj * 128 + wc * 32;
                    if (c32 < OD_ZLD) st_bf8_sw(z + (unsigned)row * OD_ZLD + c32, acc[ai][bj][m][0] * rs, acc[ai][bj][m][1] * rs, fq);
                    else if (c32 == OD_ZLD) *(f32x4*)(glow + (unsigned)row * 16 + fq * 4) = acc[ai][bj][m][0] * rs;
                }
            }
    }
};

DI void conv_weight(int wv, float*  , const float* __restrict__ src, bf16_t* __restrict__ dst, int K, int N, int Npad, const float* __restrict__ g) {
    const int tid = TID(wv); const int bid = BID(), gdim = GDIM();
    const int cpr = Npad / 8, total = K * cpr;
    for (int i = bid * NTHREADS + tid; i < total; i += gdim * NTHREADS) {
        const int k = i / cpr, c8 = (i - k * cpr) * 8;
        u32x4 w = (u32x4){0u, 0u, 0u, 0u};
        if (c8 < N) {
            const f32x4 a = *(const f32x4*)(src + (size_t)k * N + c8), b = *(const f32x4*)(src + (size_t)k * N + c8 + 4);
            const float gg = g ? g[k] : 1.0f;
            w.x = pk2(a[0] * gg, a[1] * gg); w.y = pk2(a[2] * gg, a[3] * gg); w.z = pk2(b[0] * gg, b[1] * gg); w.w = pk2(b[2] * gg, b[3] * gg);
        }
        *(u32x4*)(dst + (size_t)k * Npad + c8) = w;
    }
}

typedef const __attribute__((address_space(4))) Params* KP;
DI void prologue(int wv, KP pp, unsigned char* ws, unsigned char* smem) {
    float* tile = (float*)smem;
    const int tid = TID(wv), wid = tid >> 6, lane = tid & 63; const int bid = BID(), gdim = GDIM();
    sq_t* sq = (sq_t*)(ws + OFF_SQ);
    for (size_t i = (size_t)bid * NTHREADS + tid; i < SQ_FLOATS - R; i += (size_t)gdim * NTHREADS) sq[R + i] = 0ull;
    bf16_t* xb = (bf16_t*)(ws + OFF_XB);
    for (int row = bid * 8 + wid; row < R; row += gdim * 8) {
        float ss = 0.f;
#pragma unroll
        for (int i = 0; i < 4; ++i) {
            const size_t o = (size_t)row * 1024 + i * 256 + lane * 4;
            const f32x4 v = *(const f32x4*)(pp->x + o); ss += dot4(v); st_bf4(xb + o, v);
            if (XCOPY) *(f32x4*)(pp->out + o) = v;
        }
#pragma unroll
        for (int d = 1; d < 64; d <<= 1) ss += shx(ss, d, lane);
        if (lane == 0) sq[row] = (sq_t)(ss * 16777216.0f);
    }
    float* cs = (float*)(ws + OFF_COS); float* sn = (float*)(ws + OFF_SIN);
    for (int i = bid * NTHREADS + tid; i < R * 16; i += gdim * NTHREADS) {
        const int row = i >> 4, f = i & 15;
        const float inv_freq = 1.0f / powf(10000.0f, (float)(2 * f) / 32.0f);
        const float ang = (float)pp->pos[row] * inv_freq;
        const double a = (double)ang;
        const double kq = rint(a * 0.63661977236758134308);
        const double rr = a - kq * 1.57079632679489661923;
        const double r2 = rr * rr;
        const double sp = rr * (1.0 + r2 * (-1.0 / 6 + r2 * (1.0 / 120 + r2 * (-1.0 / 5040 + r2 * (1.0 / 362880 + r2 * (-1.0 / 39916800 + r2 * (1.0 / 6227020800.0)))))));
        const double cp = 1.0 + r2 * (-0.5 + r2 * (1.0 / 24 + r2 * (-1.0 / 720 + r2 * (1.0 / 40320 + r2 * (-1.0 / 3628800 + r2 * (1.0 / 479001600.0 + r2 * (-1.0 / 87178291200.0)))))));
        const int q = ((int)kq) & 3;
        const double sv = (q == 0) ? sp : (q == 1) ? cp : (q == 2) ? -sp : -cp;
        const double cv = (q == 0) ? cp : (q == 1) ? -sp : (q == 2) ? -cp : sp;
        cs[i] = (float)cv; sn[i] = (float)sv;
    }
    for (int j = 0; j < 2; ++j) {
        conv_weight(wv, tile, pp->ev_w_in + (size_t)j * 1024 * EV_IN, (bf16_t*)(ws + WT_EVIN) + (size_t)j * EV_IN_PAD * 1024, 1024, EV_IN, EV_IN_PAD, pp->mix_g + (2 * j) * 1024);
        conv_weight(wv, tile, pp->ev_wqb + (size_t)j * 384 * 768, (bf16_t*)(ws + WT_EVQ) + (size_t)j * 768 * 384, 384, 768, 768, pp->ev_qg + j * 384);
        conv_weight(wv, tile, pp->ev_wkvb + (size_t)j * 256 * 1024, (bf16_t*)(ws + WT_EVKV) + (size_t)j * 1024 * 256, 256, 1024, 1024, pp->ev_kvg + j * 256);
        conv_weight(wv, tile, pp->ev_wout + (size_t)j * 1024 * 1024, (bf16_t*)(ws + WT_EVOUT) + (size_t)j * 1024 * 1024, 1024, 1024, 1024, nullptr);
        conv_weight(wv, tile, pp->od_w_in + (size_t)j * 1024 * OD_IN, (bf16_t*)(ws + WT_ODIN) + (size_t)j * OD_IN_PAD * 1024, 1024, OD_IN, OD_IN_PAD, pp->mix_g + (2 * j + 1) * 1024);
        conv_weight(wv, tile, pp->od_wout + (size_t)j * 1024 * 1024, (bf16_t*)(ws + WT_ODOUT) + (size_t)j * 1024 * 1024, 1024, 1024, 1024, nullptr);
    }
    for (int L = 0; L < 4; ++L) {
        conv_weight(wv, tile, pp->w1 + (size_t)L * 1024 * 4096, (bf16_t*)(ws + WT_W1) + (size_t)L * 4096 * 1024, 1024, 4096, 4096, pp->mlp_g + L * 1024);
        conv_weight(wv, tile, pp->w2 + (size_t)L * 4096 * 1024, (bf16_t*)(ws + WT_W2) + (size_t)L * 1024 * 4096, 4096, 1024, 1024, nullptr);
    }
}

DI void conv_phase(int wv, const bf16_t* __restrict__ z, const float* __restrict__ cw  , bf16_t* __restrict__ mix) {
    const int tid0 = TID(wv); const int bid = BID(), gdim = GDIM();
    const int stride = gdim * NTHREADS, total = R * 64;
    for (int i0 = bid * NTHREADS + tid0; i0 < total; i0 += 2 * stride) {
        u32x4 ab[2], ac[2][3], av[2][3]; int row[2], c8[2]; float msk[2][3]; bool in[2];
#pragma unroll
        for (int u = 0; u < 2; ++u) {
            const int i = i0 + u * stride; in[u] = i < total; const int ii = in[u] ? i : 0;
            row[u] = ii >> 6; c8[u] = (ii & 63) * 8; const int sp = row[u] & 4095;
            const bf16_t* zr = z + (size_t)row[u] * EV_ZLD;
            ab[u] = *(const u32x4*)(zr + c8[u]);
#pragma unroll
            for (int k = 0; k < 3; ++k) {
                const int back = 2 - k; const bool ok = sp >= back; msk[u][k] = ok ? 1.0f : 0.0f;
                const bf16_t* zb_ = zr - (size_t)(ok ? back : 0) * EV_ZLD;
                ac[u][k] = *(const u32x4*)(zb_ + 512 + c8[u]); av[u][k] = *(const u32x4*)(zb_ + 1024 + c8[u]);
            }
        }
#pragma unroll
        for (int u = 0; u < 2; ++u) {
            if (!in[u]) continue;
            float y[8];
#pragma unroll
            for (int e = 0; e < 8; ++e) {
                float conv = 0.f;
#pragma unroll
                for (int k = 0; k < 3; ++k) {
                    const float c_ = (e & 1) ? bfhi(ac[u][k][e >> 1]) : bflo(ac[u][k][e >> 1]);
                    const float v_ = (e & 1) ? bfhi(av[u][k][e >> 1]) : bflo(av[u][k][e >> 1]);
                    conv += cw[k * 512 + c8[u] + e] * ((c_ * v_) * msk[u][k]);
                }
                const float abv = (e & 1) ? bfhi(ab[u][e >> 1]) : bflo(ab[u][e >> 1]);
                y[e] = abv * conv;
            }
            u32x4 w; w.x = pk2(y[0], y[1]); w.y = pk2(y[2], y[3]); w.z = pk2(y[4], y[5]); w.w = pk2(y[6], y[7]);
            *(u32x4*)(mix + (size_t)row[u] * 1024 + c8[u]) = w;
        }
    }
}

DI void attn_phase(int wv, unsigned char* smem, const bf16_t* __restrict__ Qb, const bf16_t* __restrict__ Kb, const bf16_t* __restrict__ Vt, bf16_t* __restrict__ mix) {
    constexpr int KROW = 208, VROW = 136, KBUF = 64 * KROW, VBUF = 64 * VROW, BUF = KBUF + VBUF;
    const int tid = TID(wv), wid = tid >> 6, lane = tid & 63, r = lane & 31, h = lane >> 5; const int bid = BID(), gdim = GDIM();
    for (int item = bid; item < 512; item += gdim) {
        const int pp = (item >> 3) & 7, bh = (item & 7) + 8 * ((item >> 6) & 3) + 32 * (item >> 8);
        const unsigned char* Kg = (const unsigned char*)(Kb + (size_t)bh * 4096 * 96);
        const unsigned char* Vg = (const unsigned char*)(Vt + (size_t)bh * 64 * 4096);
        for (int half = 0; half < 2; ++half) {
            const int qb = half ? 15 - pp : pp;
            const int q0 = qb * 256 + wid * 32;
            const bf16_t* Qp = Qb + ((size_t)bh * 4096 + q0 + r) * 96;
            bf16x8 qf[6];
#pragma unroll
            for (int ks = 0; ks < 6; ++ks) qf[ks] = *(const bf16x8*)(Qp + 16 * ks + 8 * h);
            asm volatile("s_waitcnt vmcnt(0)" : "+v"(qf[0]), "+v"(qf[1]), "+v"(qf[2]), "+v"(qf[3]), "+v"(qf[4]), "+v"(qf[5]) :: "memory");
            f32x16 o0, o1;
#pragma unroll
            for (int i = 0; i < 16; ++i) { o0[i] = 0.f; o1[i] = 0.f; }
            float mrun = -INFINITY, lrun = 0.f;
            const int nt = 4 * (qb + 1);
            __syncthreads();
            {
                const u32x4 k0v = *(const u32x4*)(Kg + tid * 16);
                u32x4 k1v; if (tid < 256) k1v = *(const u32x4*)(Kg + (tid + 512) * 16);
                const u32x4 vv = *(const u32x4*)(Vg + (size_t)(tid >> 3) * 8192 + (tid & 7) * 16);
                *(u32x4*)(smem + (tid / 12) * KROW + (tid % 12) * 16) = k0v;
                if (tid < 256) *(u32x4*)(smem + ((tid + 512) / 12) * KROW + ((tid + 512) % 12) * 16) = k1v;
                unsigned char* vd = smem + KBUF + (tid >> 3) * VROW + (tid & 7) * 16;
                *(u32x2*)vd = (u32x2){vv.x, vv.y}; *(u32x2*)(vd + 8) = (u32x2){vv.z, vv.w};
            }
            __syncthreads();
            for (int kt = 0; kt < nt; ++kt) {
                const bool more = kt + 1 < nt;
                u32x4 k0v, k1v, vv;
                if (more) {
                    const unsigned char* kg = Kg + (size_t)(kt + 1) * 12288;
                    k0v = *(const u32x4*)(kg + tid * 16);
                    if (tid < 256) k1v = *(const u32x4*)(kg + (tid + 512) * 16);
                    vv = *(const u32x4*)(Vg + (size_t)(tid >> 3) * 8192 + (kt + 1) * 128 + (tid & 7) * 16);
                }
                const unsigned char* kb_ = smem + (kt & 1) * BUF; const unsigned char* vb_ = kb_ + KBUF;
                const int key0 = kt * 64;
                if (key0 <= q0 + 31) {
                    f32x16 s0, s1;
#pragma unroll
                    for (int i = 0; i < 16; ++i) { s0[i] = 0.f; s1[i] = 0.f; }
                    bf16x8 ka0[6], ka1[6];
#pragma unroll
                    for (int ks = 0; ks < 6; ++ks) { ka0[ks] = *(const bf16x8*)(kb_ + r * KROW + ks * 32 + h * 16); ka1[ks] = *(const bf16x8*)(kb_ + (32 + r) * KROW + ks * 32 + h * 16); }
                    __builtin_amdgcn_sched_barrier(0);
#pragma unroll
                    for (int ks = 0; ks < 6; ++ks) { s0 = MFMA32(ka0[ks], qf[ks], s0); s1 = MFMA32(ka1[ks], qf[ks], s1); }
                    if (key0 + 63 > q0) {
                        const int qpos = q0 + r;
#pragma unroll
                        for (int i = 0; i < 16; ++i) { const int key = key0 + crow(i, h); if (key > qpos) s0[i] = -INFINITY; if (key + 32 > qpos) s1[i] = -INFINITY; }
                    }
                    float mx = s0[0];
#pragma unroll
                    for (int i = 1; i < 16; ++i) mx = fmaxf(mx, s0[i]);
#pragma unroll
                    for (int i = 0; i < 16; ++i) mx = fmaxf(mx, s1[i]);
                    mx = fmaxf(mx, shx32(mx, lane));
                    const float mnew = fmaxf(mrun, mx);
                    const float alpha = __builtin_amdgcn_exp2f(mrun - mnew);
                    float ls = 0.f;
#pragma unroll
                    for (int i = 0; i < 16; ++i) { s0[i] = __builtin_amdgcn_exp2f(s0[i] - mnew); s1[i] = __builtin_amdgcn_exp2f(s1[i] - mnew); ls += s0[i] + s1[i]; }
                    lrun = lrun * alpha + ls; mrun = mnew;
#pragma unroll
                    for (int i = 0; i < 16; ++i) { o0[i] *= alpha; o1[i] *= alpha; }
                    bf16x8 pf[4];
                    pf[0] = pack8(s0, 0); pf[1] = pack8(s0, 1); pf[2] = pack8(s1, 0); pf[3] = pack8(s1, 1);
                    bf16x8 va0[4], va1[4];
#pragma unroll
                    for (int kk = 0; kk < 4; ++kk) {
                        const int koff = (kk >> 1) * 32 + (kk & 1) * 16 + 4 * h;
                        const s16x4 lo0 = *(const s16x4*)(vb_ + r * VROW + koff * 2), hi0 = *(const s16x4*)(vb_ + r * VROW + (koff + 8) * 2);
                        const s16x4 lo1 = *(const s16x4*)(vb_ + (32 + r) * VROW + koff * 2), hi1 = *(const s16x4*)(vb_ + (32 + r) * VROW + (koff + 8) * 2);
                        va0[kk] = __builtin_shufflevector(lo0, hi0, 0, 1, 2, 3, 4, 5, 6, 7);
                        va1[kk] = __builtin_shufflevector(lo1, hi1, 0, 1, 2, 3, 4, 5, 6, 7);
                    }
                    __builtin_amdgcn_sched_barrier(0);
#pragma unroll
                    for (int kk = 0; kk < 4; ++kk) { o0 = MFMA32(va0[kk], pf[kk], o0); o1 = MFMA32(va1[kk], pf[kk], o1); }
                }
                if (more) {
                    unsigned char* nb = smem + ((kt + 1) & 1) * BUF;
                    *(u32x4*)(nb + (tid / 12) * KROW + (tid % 12) * 16) = k0v;
                    if (tid < 256) *(u32x4*)(nb + ((tid + 512) / 12) * KROW + ((tid + 512) % 12) * 16) = k1v;
                    unsigned char* vd = nb + KBUF + (tid >> 3) * VROW + (tid & 7) * 16;
                    *(u32x2*)vd = (u32x2){vv.x, vv.y}; *(u32x2*)(vd + 8) = (u32x2){vv.z, vv.w};
                }
                __syncthreads();
            }
            lrun += shx32(lrun, lane);
            const float inv = 1.0f / lrun;
            const int b = bh >> 3, head = bh & 7;
            bf16_t* op = mix + ((size_t)b * 4096 + q0 + r) * 1024 + 512 + head * 64;
#pragma unroll
            for (int g = 0; g < 4; g += 2) {
                st_bf8_sw32(op + 8 * g, (f32x4){o0[4 * g] * inv, o0[4 * g + 1] * inv, o0[4 * g + 2] * inv, o0[4 * g + 3] * inv},
                            (f32x4){o0[4 * g + 4] * inv, o0[4 * g + 5] * inv, o0[4 * g + 6] * inv, o0[4 * g + 7] * inv}, h);
                st_bf8_sw32(op + 32 + 8 * g, (f32x4){o1[4 * g] * inv, o1[4 * g + 1] * inv, o1[4 * g + 2] * inv, o1[4 * g + 3] * inv},
                            (f32x4){o1[4 * g + 4] * inv, o1[4 * g + 5] * inv, o1[4 * g + 6] * inv, o1[4 * g + 7] * inv}, h);
            }
        }
    }
}

DI void gla_prep(int wv, bool dry, unsigned char* smem, bf16_t* __restrict__ z, const float* __restrict__ glow, const float* __restrict__ wg2, const float* __restrict__ bg2,
                 bf16_t* __restrict__ KLT, bf16_t* __restrict__ AT, float* __restrict__ DEC) {
    float* s_glow = (float*)smem;
    float* s_seg = (float*)(smem + 4096);
    unsigned char* s_qe = smem + 8192;
    unsigned char* s_ke = s_qe + 64 * 272;
    const int tid = TID(wv), wid = tid >> 6, lane = tid & 63, r = lane & 31, h = lane >> 5; const int bid = BID(), gdim = GDIM();
    const int dk = tid & 127, tq = tid >> 7;
    f32x4 gpre = (f32x4){0.f, 0.f, 0.f, 0.f};
    if (bid < 2048 && tid < 256) gpre = ((const f32x4*)(glow + ((size_t)(bid >> 8) * 4096 + (bid & 63) * 64) * 16))[tid];
    for (int item = bid; item < 2048; item += gdim) {
        const int n = item & 63, hh = (item >> 6) & 3, b = item >> 8;
        const size_t row0 = (size_t)b * 4096 + n * 64;
        bf16_t qraw[16], kraw[16];
#pragma unroll
        for (int tt = 0; tt < 16; ++tt) { const bf16_t* zr = z + (row0 + tq * 16 + tt) * OD_ZLD + hh * 128 + dk; qraw[tt] = zr[0]; kraw[tt] = zr[512]; }
        __syncthreads();
        if (tid < 256) {
            ((f32x4*)s_glow)[tid] = gpre;
            const int nitem = item + gdim;
            if (nitem < 2048) gpre = ((const f32x4*)(glow + ((size_t)(nitem >> 8) * 4096 + (nitem & 63) * 64) * 16))[tid];
        }
        float w[16];
#pragma unroll
        for (int j = 0; j < 16; ++j) w[j] = wg2[j * 512 + hh * 128 + dk];
        const float bb = bg2[hh * 128 + dk];
        __syncthreads();
        float la[16]; float run = 0.f;
#pragma unroll
        for (int tt = 0; tt < 16; ++tt) {
            const int t = tq * 16 + tt; float xg = bb;
#pragma unroll
            for (int j = 0; j < 16; ++j) xg += s_glow[t * 16 + j] * w[j];
            const float ls = fminf(xg, 0.f) - 0.6931471805599453f * __builtin_amdgcn_logf(1.0f + __expf(-fabsf(xg)));
            run += ls * (1.0f / 16.0f); la[tt] = run;
        }
        s_seg[tq * 128 + dk] = run;
        __syncthreads();
        float pre = 0.f, tot = 0.f;
#pragma unroll
        for (int s = 0; s < 4; ++s) { const float v = s_seg[s * 128 + dk]; if (s < tq) pre += v; tot += v; }
        unsigned klp[8];
        const float etot = __expf(tot);
#pragma unroll
        for (int tt = 0; tt < 16; tt += 2) {
            float klv[2];
#pragma unroll
            for (int e = 0; e < 2; ++e) {
                const int t = tq * 16 + tt + e; const float bc = pre + la[tt + e];
                bf16_t* zr = z + (row0 + t) * OD_ZLD + hh * 128 + dk;
                const float q = bf2f(qraw[tt + e]), k = bf2f(kraw[tt + e]);
                const float e1 = __expf(bc), e2 = __builtin_amdgcn_rcpf(e1);
                const bf16_t qe = f2bf(q * GLA_QSCALE * e1), ke = f2bf(k * e2);
                klv[e] = k * (etot * e2);
                if (!dry) zr[0] = qe;
                *(bf16_t*)(s_qe + t * 272 + dk * 2) = qe; *(bf16_t*)(s_ke + t * 272 + dk * 2) = ke;
            }
            klp[tt >> 1] = pk2(klv[0], klv[1]);
        }
        {
            u32x4* kd = (u32x4*)(KLT + ((size_t)item * 128 + dk) * 64 + tq * 16);
            if (!dry) { kd[0] = (u32x4){klp[0], klp[1], klp[2], klp[3]}; kd[1] = (u32x4){klp[4], klp[5], klp[6], klp[7]}; }
        }
        if (tq == 0 && !dry) DEC[(size_t)item * 128 + dk] = etot;
        __syncthreads();
        if (wid < 3) {
            const int jb = (wid == 2), ib = (wid >= 1);
            f32x16 acc;
#pragma unroll
            for (int i = 0; i < 16; ++i) acc[i] = 0.f;
            bf16x8 pa[8], pb[8];
#pragma unroll
            for (int ks = 0; ks < 8; ++ks) { pa[ks] = *(const bf16x8*)(s_ke + (jb * 32 + r) * 272 + ks * 32 + h * 16); pb[ks] = *(const bf16x8*)(s_qe + (ib * 32 + r) * 272 + ks * 32 + h * 16); }
            __builtin_amdgcn_sched_barrier(0);
#pragma unroll
            for (int ks = 0; ks < 8; ++ks) acc = MFMA32(pa[ks], pb[ks], acc);
            const int i_tok = ib * 32 + r;
#pragma unroll
            for (int g = 0; g < 4; g += 2) {
                f32x4 v, v2;
#pragma unroll
                for (int e = 0; e < 4; ++e) { const int j = jb * 32 + 8 * g + 4 * h + e; v[e] = (j <= i_tok) ? acc[4 * g + e] : 0.f; v2[e] = (j + 8 <= i_tok) ? acc[4 * g + 4 + e] : 0.f; }
                if (!dry) st_bf8_sw32(AT + ((size_t)item * 64 + i_tok) * 64 + jb * 32 + 8 * g, v, v2, h);
            }
        } else if (wid == 3) {
#pragma unroll
            for (int g = 0; g < 4; ++g) if (!dry) *(u32x2*)(AT + ((size_t)item * 64 + r) * 64 + 32 + 8 * g + 4 * h) = (u32x2){0u, 0u};
        }
    }
}

DI void gla_scan(int wv, bool dry, unsigned char* smem, bf16_t* __restrict__ z, const bf16_t* __restrict__ KLT, const bf16_t* __restrict__ AT, const float* __restrict__ DEC, sq_t* __restrict__ sq_o) {
    constexpr int QE_OFF = 0, KL_OFF = 17408, AT_OFF = KL_OFF + 18432, VT_OFF = AT_OFF + 9216, DEC_OFF = VT_OFF + 4608, BUF = DEC_OFF + 512;
    constexpr int ST_OFF = 2 * BUF, ST_SZ = 32 * 272;
    const int tid = TID(wv), wid = tid >> 6, lane = tid & 63, r = lane & 31, h = lane >> 5; const int bid = BID(), gdim = GDIM();
    for (int item = bid; item < 256; item += gdim) {
        const int dvs = (item >> 3) & 7, gbh = (item & 7) + 8 * (item >> 6), hh = gbh & 3, b = gbh >> 2;
        const size_t ci0 = (size_t)(b * 4 + hh) * 64;
        f32x16 S;
#pragma unroll
        for (int i = 0; i < 16; ++i) S[i] = 0.f;
        __syncthreads();
        for (int i = tid; i < ST_SZ / 4; i += NTHREADS) ((unsigned*)(smem + ST_OFF))[i] = 0u;
#define GLA_DECL(P) u32x4 P##q0, P##q1, P##k0, P##k1, P##a; u32x2 P##v; float P##d = 0.f;
#define GLA_LOAD(P, n_) do { const size_t ci = ci0 + (n_); const size_t row0 = (size_t)b * 4096 + (size_t)(n_) * 64; \
            P##q0 = *(const u32x4*)(z + (row0 + (tid >> 4)) * OD_ZLD + hh * 128 + (tid & 15) * 8); \
            P##q1 = *(const u32x4*)(z + (row0 + 32 + (tid >> 4)) * OD_ZLD + hh * 128 + (tid & 15) * 8); \
            P##k0 = *(const u32x4*)(KLT + ci * 8192 + (size_t)tid * 8); P##k1 = *(const u32x4*)(KLT + ci * 8192 + (size_t)(tid + 512) * 8); \
            P##a = *(const u32x4*)(AT + ci * 4096 + (size_t)tid * 8); \
            P##v = *(const u32x2*)(z + (row0 + (tid >> 3)) * OD_ZLD + 1024 + hh * 256 + dvs * 32 + (tid & 7) * 4); \
            if (tid < 128) P##d = DEC[ci * 128 + tid]; } while (0)
#define GLA_STORE(P, bufp) do { unsigned char* bp_ = (bufp); \
            *(u32x4*)(bp_ + QE_OFF + (tid >> 4) * 272 + (tid & 15) * 16) = P##q0; *(u32x4*)(bp_ + QE_OFF + (32 + (tid >> 4)) * 272 + (tid & 15) * 16) = P##q1; \
            *(u32x4*)(bp_ + KL_OFF + (tid >> 3) * 144 + (tid & 7) * 16) = P##k0; *(u32x4*)(bp_ + KL_OFF + (64 + (tid >> 3)) * 144 + (tid & 7) * 16) = P##k1; \
            *(u32x4*)(bp_ + AT_OFF + (tid >> 3) * 144 + (tid & 7) * 16) = P##a; \
            { const int t_ = tid >> 3, d_ = (tid & 7) * 4; bf16_t* vt_ = (bf16_t*)(bp_ + VT_OFF) + t_; \
              vt_[(d_ + 0) * 72] = (bf16_t)(P##v.x & 0xffffu); vt_[(d_ + 1) * 72] = (bf16_t)(P##v.x >> 16); vt_[(d_ + 2) * 72] = (bf16_t)(P##v.y & 0xffffu); vt_[(d_ + 3) * 72] = (bf16_t)(P##v.y >> 16); } \
            if (tid < 128) ((float*)(bp_ + DEC_OFF))[tid] = P##d; } while (0)
#define GLA_COMPUTE(n_) do { \
            const unsigned char* bp = smem + ((n_) & 1) * BUF; \
            const unsigned char* stc = smem + ST_OFF + ((n_) & 1) * ST_SZ; \
            unsigned char* stn = smem + ST_OFF + (((n_) + 1) & 1) * ST_SZ; \
            if (wid < 4) { \
                const int dkb = wid; \
                const float* dec = (const float*)(bp + DEC_OFF) + dkb * 32; \
                _Pragma("unroll") for (int i = 0; i < 16; ++i) S[i] *= dec[crow(i, h)]; \
                bf16x8 sa[4], sb[4]; \
                _Pragma("unroll") for (int ks = 0; ks < 4; ++ks) { \
                    sa[ks] = *(const bf16x8*)(bp + KL_OFF + (dkb * 32 + r) * 144 + ks * 32 + h * 16); \
                    sb[ks] = *(const bf16x8*)(bp + VT_OFF + r * 144 + ks * 32 + h * 16); } \
                __builtin_amdgcn_sched_barrier(0); \
                _Pragma("unroll") for (int ks = 0; ks < 4; ++ks) S = MFMA32(sa[ks], sb[ks], S); \
                _Pragma("unroll") for (int g = 0; g < 4; ++g) { \
                    u32x2 wv_; wv_.x = pk2(S[4 * g], S[4 * g + 1]); wv_.y = pk2(S[4 * g + 2], S[4 * g + 3]); \
                    *(u32x2*)(stn + r * 272 + (dkb * 32 + 8 * g + 4 * h) * 2) = wv_; } \
            } else if (wid < 6) { \
                const int ib = wid - 4; \
                f32x16 acc; \
                _Pragma("unroll") for (int i = 0; i < 16; ++i) acc[i] = 0.f; \
                bf16x8 oa[12], ob[12];        \
                _Pragma("unroll") for (int ks = 0; ks < 4; ++ks) { \
                    oa[ks] = *(const bf16x8*)(bp + VT_OFF + r * 144 + ks * 32 + h * 16); \
                    ob[ks] = *(const bf16x8*)(bp + AT_OFF + (ib * 32 + r) * 144 + ks * 32 + h * 16); } \
                _Pragma("unroll") for (int ks = 0; ks < 8; ++ks) { \
                    oa[4 + ks] = *(const bf16x8*)(stc + r * 272 + ks * 32 + h * 16); \
                    ob[4 + ks] = *(const bf16x8*)(bp + QE_OFF + (ib * 32 + r) * 272 + ks * 32 + h * 16); } \
                __builtin_amdgcn_sched_barrier(0); \
                _Pragma("unroll") for (int ks = 0; ks < 12; ++ks) acc = MFMA32(oa[ks], ob[ks], acc); \
                const size_t row = (size_t)b * 4096 + (size_t)(n_) * 64 + ib * 32 + r; \
                bf16_t* op = z + row * OD_ZLD + 1024 + hh * 256 + dvs * 32; \
                float ss = 0.f; \
                _Pragma("unroll") for (int g = 0; g < 4; g += 2) { \
                    const f32x4 v = (f32x4){acc[4 * g], acc[4 * g + 1], acc[4 * g + 2], acc[4 * g + 3]}; \
                    const f32x4 v2 = (f32x4){acc[4 * g + 4], acc[4 * g + 5], acc[4 * g + 6], acc[4 * g + 7]}; \
                    ss += dot4(v); ss += dot4(v2); if (!dry) st_bf8_sw32(op + 8 * g, v, v2, h); } \
                ss += shx32(ss, lane); \
                if (h == 0 && !dry) sq_add(sq_o + row * 4 + hh, ss); \
            } } while (0)
        GLA_DECL(ra) GLA_DECL(rb)
        GLA_LOAD(ra, 0);
        GLA_STORE(ra, smem);
        GLA_LOAD(ra, 1); GLA_LOAD(rb, 2);
        __syncthreads();
#pragma unroll 1
        for (int n = 0; n < 64; n += 2) {
            GLA_COMPUTE(n);
            GLA_STORE(ra, smem + ((n + 1) & 1) * BUF);
            if (n + 3 < 64) GLA_LOAD(ra, n + 3);
            __syncthreads();
            GLA_COMPUTE(n + 1);
            if (n + 2 < 64) GLA_STORE(rb, smem + (n & 1) * BUF);
            if (n + 4 < 64) GLA_LOAD(rb, n + 4);
            __syncthreads();
        }
    }
#undef GLA_DECL
#undef GLA_LOAD
#undef GLA_STORE
#undef GLA_COMPUTE
}

DI void gla_gate(int wv, const bf16_t* __restrict__ z, const sq_t* __restrict__ sq_o, const float* __restrict__ og, bf16_t* __restrict__ mix) {
    const int tid0 = TID(wv); const int bid = BID(), gdim = GDIM();
    for (int i = bid * NTHREADS + tid0; i < R * 128; i += gdim * NTHREADS) {
        const int row = i >> 7, c8 = (i & 127) * 8, hh = c8 >> 8;
        const float rs = rsqrtf(sq_get(sq_o + (size_t)row * 4 + hh) * (1.0f / 256.0f) + EPS);
        const u32x4 o8 = *(const u32x4*)(z + (size_t)row * OD_ZLD + 1024 + c8), g8 = *(const u32x4*)(z + (size_t)row * OD_ZLD + 2048 + c8);
        float y[8];
#pragma unroll
        for (int e = 0; e < 8; ++e) {
            const float o = (e & 1) ? bfhi(o8[e >> 1]) : bflo(o8[e >> 1]);
            const float g = (e & 1) ? bfhi(g8[e >> 1]) : bflo(g8[e >> 1]);
            y[e] = o * rs * og[(c8 & 255) + e] * (g / (1.0f + __expf(-g)));
        }
        u32x4 w; w.x = pk2(y[0], y[1]); w.y = pk2(y[2], y[3]); w.z = pk2(y[4], y[5]); w.w = pk2(y[6], y[7]);
        *(u32x4*)(mix + (size_t)row * 1024 + c8) = w;
    }
}

DI void final_phase(int wv, float* out, const sq_t* __restrict__ sq, const float* __restrict__ g) {
    const int tid0 = TID(wv); const int bid = BID(), gdim = GDIM();
    const int stride = gdim * NTHREADS, total = R * 256;
    for (int i0 = bid * NTHREADS + tid0; i0 < total; i0 += 8 * stride) {
        f32x4 v[8]; sq_t sv[8]; int row[8], c4[8]; bool in[8];
#pragma unroll
        for (int u = 0; u < 8; ++u) {
            const int i = i0 + u * stride; in[u] = i < total; const int ii = in[u] ? i : 0;
            row[u] = ii >> 8; c4[u] = (ii & 255) * 4;
            sv[u] = sq_raw(sq + row[u]);
            v[u] = *(const f32x4*)(out + (size_t)row[u] * 1024 + c4[u]);
        }
#pragma unroll
        for (int u = 0; u < 8; ++u) {
            if (!in[u]) continue;
            const float rs = rsqrtf(sq_cvt(sv[u]) * (1.0f / 1024.0f) + EPS);
            const f32x4 gg = *(const f32x4*)(g + c4[u]);
            *(f32x4*)(out + (size_t)row[u] * 1024 + c4[u]) = v[u] * rs * gg;
        }
    }
}

#define XB_TMO      128
#define XB_XCNT(j)  (256  + 64 * (j))
#define XB_XSUB(j)  (1280 + 64 * (j))
#define XB_XGEN(j)  (2304 + 64 * (j))
#define XB_TOP      3328
#define XB_TOPGEN   3392
#define XCD_BAR_WORDS 3456
#define XB_SPIN_CAP (1u << 18)
DI unsigned xb_ld(unsigned* p) { return __hip_atomic_load(p, __ATOMIC_RELAXED, __HIP_MEMORY_SCOPE_AGENT); }
DI unsigned xb_add(unsigned* p, unsigned v) { return __hip_atomic_fetch_add(p, v, __ATOMIC_RELAXED, __HIP_MEMORY_SCOPE_AGENT); }
DI unsigned xb_xcc_id() { return (unsigned)__builtin_amdgcn_s_getreg((3 << 11) | 20) & 0xFu; }
#define XB_SPIN(cond, bar) do { unsigned _sp = 0; while (cond) { __builtin_amdgcn_s_sleep(1); \
    if ((++_sp & 255u) == 0u) { if (xb_ld(&(bar)[XB_TMO])) break; if (_sp > XB_SPIN_CAP) { atomicAdd(&(bar)[XB_TMO], 1u); break; } } } } while (0)
DI void xcd_barrier_complete(unsigned* bar, unsigned x, unsigned& nloc, unsigned& nx) {
    const unsigned G = gridDim.x;
    unsigned sum, cnt, mine, sp = 0u;
    for (;;) {
        sum = 0u; cnt = 0u; mine = 0u;
#pragma unroll
        for (unsigned j = 0; j < 16; ++j) { const unsigned c = xb_ld(&bar[XB_XCNT(j)]); sum += c; cnt += (c > 0u) ? 1u : 0u; mine = (j == x) ? c : mine; }
        if (sum == G) break;
        __builtin_amdgcn_s_sleep(1);
        if ((++sp & 255u) == 0u) { if (xb_ld(&bar[XB_TMO])) break; if (sp > XB_SPIN_CAP) { atomicAdd(&bar[XB_TMO], 1u); break; } }
    }
    nloc = mine > 0u ? mine : 1u; nx = cnt > 0u ? cnt : 1u;
}
DI void xcd_barrier(unsigned* bar, volatile LAS unsigned* st, int tid) {
    asm volatile("s_waitcnt vmcnt(0) lgkmcnt(0)" ::: "memory");
    __syncthreads();
    if (tid == 0) {
        __builtin_amdgcn_s_waitcnt(0);
        const unsigned x = xb_xcc_id();
        unsigned nloc = st[0], nx = st[1];
        if (nloc == 0u) { xcd_barrier_complete(bar, x, nloc, nx); st[0] = nloc; st[1] = nx; }
        const unsigned old = xb_add(&bar[XB_XSUB(x)], 1u);
        const unsigned gen = old / nloc;
        if (old + 1u == (gen + 1u) * nloc) {
            __builtin_amdgcn_fence(__ATOMIC_RELEASE, "agent");
            asm volatile("s_waitcnt vmcnt(0)" ::: "memory");
            const unsigned og = xb_add(&bar[XB_TOP], 1u);
            const unsigned tg = og / nx;
            if (og + 1u == (tg + 1u) * nx) xb_add(&bar[XB_TOPGEN], 1u);
            else XB_SPIN(xb_ld(&bar[XB_TOPGEN]) == tg, bar);
            __builtin_amdgcn_fence(__ATOMIC_ACQUIRE, "agent");
            xb_add(&bar[XB_XGEN(x)], 1u);
            asm volatile("s_waitcnt vmcnt(0)" ::: "memory");
        } else {
            XB_SPIN(xb_ld(&bar[XB_XGEN(x)]) == gen, bar);
            __builtin_amdgcn_fence(__ATOMIC_ACQUIRE, "agent");
            asm volatile("s_waitcnt vmcnt(0)" ::: "memory");
        }
    }
    __syncthreads();
}

__global__ void __launch_bounds__(NTHREADS, 2) mega(Params p) {
    extern __shared__ __attribute__((aligned(16))) unsigned char smem[];
    cg::grid_group grid = cg::this_grid();
    const int wv = __builtin_amdgcn_readfirstlane((int)(threadIdx.x >> 6));
    KP kp = (KP)__builtin_amdgcn_kernarg_segment_ptr();
    const int lo = kp->lo, hi = kp->hi;
    int ph = 0;
#define PH_BEGIN { if (ph >= lo && ph < hi) { KP pp = kp; asm volatile("" : "+s"(pp)); unsigned char* ws = pp->ws; \
    sq_t* sq = (sq_t*)(ws + OFF_SQ); const float* cs = (const float*)(ws + OFF_COS); const float* sn = (const float*)(ws + OFF_SIN); \
    bf16_t* xb = (bf16_t*)(ws + OFF_XB); bf16_t* zb = (bf16_t*)(ws + U_Z); (void)sq; (void)cs; (void)sn; (void)xb; (void)zb;
#define PH_END if (ph + 1 < hi) { xcd_barrier((unsigned*)(ws + OFF_BAR), bst, TID(wv)); if (REP & 16) xcd_barrier((unsigned*)(ws + OFF_BAR), bst, TID(wv)); } } ++ph; }

    if (hi < 0) grid.sync();
    volatile LAS unsigned* bst = (volatile LAS unsigned*)((LAS unsigned char*)smem + 131072);
    if (hi - lo > 1) {
        const int t0 = TID(wv);
        if (t0 < 2) bst[t0] = 0u;
        __syncthreads();
        if (t0 == 0) (void)xb_add(&((unsigned*)(kp->ws + OFF_BAR))[XB_XCNT(xb_xcc_id())], 1u);
    }

    PH_BEGIN for (int rep = 0; rep < ((REP & 8) ? 2 : 1); ++rep) prologue(wv, pp, ws, smem); PH_END

    for (int L = 0; L < 4; ++L) {
        const int j = L >> 1;
        const bool even = (L & 1) == 0;
        for (int half = 0; half < 2; ++half) {
            if (half == 0) {
                if (even) { if (EN2 & 1) {
                    PH_BEGIN {
                        EpiInEven e{zb, sq + (size_t)L * R, sq + (size_t)(9 + j) * R, sq + (size_t)(11 + j) * R, (bf16_t*)(ws + U_EV_K), cs, sn};
                        if (EN & 2) gemm_phase(wv, smem, xb, 1024, (const bf16_t*)(ws + WT_EVIN) + (size_t)j * EV_IN_PAD * 1024, 0, 1024, R / 256, EV_IN_PAD / 256, e);
                    } PH_END
                    PH_BEGIN {
                        for (int rep = 0; rep < ((REP & 4) ? 2 : 1); ++rep) {
                        EpiQ eq{(bf16_t*)(ws + U_EV_Q), sq + (size_t)(9 + j) * R, cs, sn};
                        if (EN & 4) gemm_phase(wv, smem, zb + 1536, EV_ZLD, (const bf16_t*)(ws + WT_EVQ) + (size_t)j * 768 * 384, 0, 384, R / 256, 3, eq);
                        EpiKV ek{(bf16_t*)(ws + U_EV_K), (bf16_t*)(ws + U_EV_VT), sq + (size_t)(11 + j) * R};
                        if (EN & 8) gemm_phase(wv, smem, zb + 1920, EV_ZLD, (const bf16_t*)(ws + WT_EVKV) + (size_t)j * 1024 * 256, 0, 256, R / 256, 4, ek);
                        if (EN & 16) conv_phase(wv, zb, pp->ev_conv + (size_t)j * 3 * 512, (bf16_t*)(ws + U_EV_MIX)); }
                    } PH_END
                    PH_BEGIN for (int rep = 0; rep < ((REP & 2) ? 2 : 1); ++rep) attn_phase(wv, smem, (const bf16_t*)(ws + U_EV_Q), (const bf16_t*)(ws + U_EV_K), (const bf16_t*)(ws + U_EV_VT), (bf16_t*)(ws + U_EV_MIX)); PH_END
                } } else { if (EN2 & 2) {
                    PH_BEGIN {
                        EpiInOdd e{zb, (float*)(ws + OFF_GLOW), sq + (size_t)L * R};
                        if (EN & 64) gemm_phase(wv, smem, xb, 1024, (const bf16_t*)(ws + WT_ODIN) + (size_t)j * OD_IN_PAD * 1024, 0, 1024, R / 256, OD_IN_PAD / 256, e);
                    } PH_END
                    PH_BEGIN for (int rep = ((REP & 32) ? 0 : 1); rep < 2; ++rep) gla_prep(wv, rep == 0, smem, zb, (const float*)(ws + OFF_GLOW), pp->od_wg2 + (size_t)j * 16 * 512, pp->od_bg2 + (size_t)j * 512, (bf16_t*)(ws + U_OD_KLT), (bf16_t*)(ws + U_OD_AT), (float*)(ws + U_OD_DEC)); PH_END
                    PH_BEGIN for (int rep = ((REP & 64) ? 0 : 1); rep < 2; ++rep) gla_scan(wv, rep == 0, smem, zb, (const bf16_t*)(ws + U_OD_KLT), (const bf16_t*)(ws + U_OD_AT), (const float*)(ws + U_OD_DEC), sq + (size_t)(13 + 4 * j) * R); PH_END
                    PH_BEGIN for (int rep = ((REP & 128) ? 0 : 1); rep < 2; ++rep) gla_gate(wv, zb, sq + (size_t)(13 + 4 * j) * R, pp->od_og + (size_t)j * 256, (bf16_t*)(ws + U_OD_MIX)); PH_END
                } }
            } else if (EN2 & 4) {
                PH_BEGIN {
                    EpiMlp1 e{(bf16_t*)(ws + U_HID), sq + (size_t)(((even ? (EN2 & 1) : (EN2 & 2)) ? 4 + L : L)) * R};
                    for (int rep = 0; rep < ((REP & 1) ? 2 : 1); ++rep) gemm_phase(wv, smem, xb, 1024, (const bf16_t*)(ws + WT_W1) + (size_t)L * 4096 * 1024, 0, 1024, R / 256, 16, e);
                } PH_END
            }
            if (half == 0 ? (even ? (EN2 & 1) : (EN2 & 2)) : (EN2 & 4)) PH_BEGIN {
                const bf16_t* A; const bf16_t* Bt; int K; sq_t* sqn;
                if (half == 0) {
                    A = (const bf16_t*)(ws + (even ? U_EV_MIX : U_OD_MIX));
                    Bt = (const bf16_t*)(ws + (even ? WT_EVOUT : WT_ODOUT)) + (size_t)j * 1024 * 1024; K = 1024; sqn = sq + (size_t)(4 + L) * R;
                } else {
                    A = (const bf16_t*)(ws + U_HID); Bt = (const bf16_t*)(ws + WT_W2) + (size_t)L * 1024 * 4096; K = 4096; sqn = (L < 3) ? sq + (size_t)(L + 1) * R : sq + (size_t)8 * R;
                }
                const float* xin = (!XCOPY && L == 0 && half == 0) ? pp->x : pp->out;
                EpiResid e{xin, pp->out, xb, sqn, !(L == 3 && half == 1)};
                if (EN & 2048) gemm_phase(wv, smem, A, K, Bt, half, K, R / 256, 4, e);
            } PH_END
        }
    }
    PH_BEGIN if (EN & 4096) final_phase(wv, pp->out, sq + (size_t)8 * R, pp->fin_g); PH_END
}
constexpr int N_PHASES = 1 + 2 * 6 + 2 * 7 + 1;

extern "C" void kernel_launch(void* const* d_in, const int* in_sizes, int n_in, void* d_out, int out_size, void* d_ws, size_t ws_size, hipStream_t stream) {
    static int grid_blocks = 0;
    if (grid_blocks == 0) {
        if (n_in != 19 || ws_size < WS_NEED) { fprintf(stderr, "kernel_launch: need 19 inputs and %zu bytes of workspace, got %d and %zu\n", (size_t)WS_NEED, n_in, ws_size); grid_blocks = -1; return; }
        int dev = 0, cus = 0, per_cu = 0;
        hipGetDevice(&dev);
        hipDeviceGetAttribute(&cus, hipDeviceAttributeMultiprocessorCount, dev);
        if (hipFuncSetAttribute((const void*)mega, hipFuncAttributeMaxDynamicSharedMemorySize, LDS_BYTES) != hipSuccess) { fprintf(stderr, "kernel_launch: hipFuncSetAttribute failed\n"); grid_blocks = -1; return; }
        if (hipOccupancyMaxActiveBlocksPerMultiprocessor(&per_cu, (const void*)mega, NTHREADS, LDS_BYTES) != hipSuccess || per_cu < 1) { fprintf(stderr, "kernel_launch: occupancy query says %d\n", per_cu); per_cu = 1; (void)hipGetLastError(); }
        grid_blocks = cus * per_cu;
    }
    if (grid_blocks < 0) return;
    Params p{};
    p.x = (const float*)d_in[0]; p.pos = (const int*)d_in[1]; p.mix_g = (const float*)d_in[2]; p.mlp_g = (const float*)d_in[3]; p.fin_g = (const float*)d_in[4];
    p.ev_w_in = (const float*)d_in[5]; p.ev_conv = (const float*)d_in[6]; p.ev_qg = (const float*)d_in[7]; p.ev_wqb = (const float*)d_in[8]; p.ev_kvg = (const float*)d_in[9];
    p.ev_wkvb = (const float*)d_in[10]; p.ev_wout = (const float*)d_in[11]; p.od_w_in = (const float*)d_in[12]; p.od_wg2 = (const float*)d_in[13]; p.od_bg2 = (const float*)d_in[14];
    p.od_og = (const float*)d_in[15]; p.od_wout = (const float*)d_in[16]; p.w1 = (const float*)d_in[17]; p.w2 = (const float*)d_in[18];
    p.out = (float*)d_out; p.ws = (unsigned char*)d_ws;
#if MULTI_LAUNCH
    for (int k = 0; k < N_PHASES; ++k) {
        p.lo = k; p.hi = k + 1;
        hipLaunchKernelGGL(mega, dim3(grid_blocks), dim3(NTHREADS), LDS_BYTES, stream, p);
    }
#else
    p.lo = 0; p.hi = N_PHASES;
    if (hipMemsetAsync((unsigned char*)d_ws + OFF_BAR, 0, 16384, stream) != hipSuccess) { fprintf(stderr, "kernel_launch: memset of barrier words failed\n"); return; }
    void* args[] = {&p};
    hipError_t e = hipLaunchCooperativeKernel((const void*)mega, dim3(grid_blocks), dim3(NTHREADS), args, LDS_BYTES, stream);
    if (e != hipSuccess) fprintf(stderr, "cooperative launch failed: %s (grid %d)\n", hipGetErrorString(e), grid_blocks);
#endif
}
```
